# Optimizing an MI355X kernel written in HIP

```python
import jax, jax.numpy as jnp
from jax import lax
import numpy as np

D_MODEL = 1024
BATCH = 4
SEQ = 8192
DEPTH = 4

GRID_W = 64
CTX_LEN = 256

D_FF = 2816

GLA_HEADS = 4
GLA_DK = 64
GLA_DV = 128
GLA_QK = GLA_HEADS * GLA_DK
GLA_V = GLA_HEADS * GLA_DV
GLA_RANK = 16
GLA_TAU = 16.0
GLA_CHUNK = 64

MLA_HEADS = 4
MLA_D_NOPE = 128
MLA_D_ROPE = 64
MLA_D_V = 128
MLA_D_CQ = 384
MLA_D_CKV = 128
MLA_SCALE = (MLA_D_NOPE + MLA_D_ROPE) ** -0.5

NA_HEADS = 16
NA_HEAD_DIM = 64
NA_KH = 8
NA_KW = 16

ROPE_BASE = 10000.0
Q_BLOCK = 128
EPS = 1e-6
N_EVEN = (DEPTH + 1) // 2
N_ODD = DEPTH // 2
ALPHA = (2 * DEPTH) ** 0.25
BETA = (8 * DEPTH) ** -0.25

EVEN_SIZES = (GLA_QK, GLA_QK, GLA_V, GLA_V, GLA_RANK, GLA_RANK, MLA_D_CQ, MLA_D_CKV, MLA_D_ROPE)
EVEN_OUT_IN = GLA_V + MLA_HEADS * MLA_D_V
NA_WIDTH = NA_HEADS * NA_HEAD_DIM

kernel_name = 'hybrid_gla_mla_natten_macaron_deepnorm'


def layer_norm(x):
    xf = x.astype(jnp.float32)
    mu = jnp.mean(xf, axis=-1, keepdims=True)
    var = jnp.mean(jnp.square(xf - mu), axis=-1, keepdims=True)
    return ((xf - mu) * lax.rsqrt(var + EPS)).astype(x.dtype)


def rms_norm(x, g):
    xf = x.astype(jnp.float32)
    y = xf * lax.rsqrt(jnp.mean(jnp.square(xf), axis=-1, keepdims=True) + EPS)
    return y.astype(x.dtype) * g


def modulate(x, shift, scale):
    return x * (1.0 + scale) + shift


def post_norm(x, y):
    return layer_norm(ALPHA * x + y)


def swiglu(h, w_in, w_out):
    gate, up = jnp.split(h @ w_in, 2, axis=-1)
    return (jax.nn.silu(gate) * up) @ w_out


def axial_rope(n_tokens):
    t = jnp.arange(n_tokens)
    row = (t // GRID_W).astype(jnp.float32)
    col = (t % GRID_W).astype(jnp.float32)
    n_freq = MLA_D_ROPE // 4
    inv = ROPE_BASE ** (-jnp.arange(n_freq, dtype=jnp.float32) / n_freq)
    ang = jnp.concatenate([row[:, None] * inv, col[:, None] * inv], axis=-1)
    return jnp.cos(ang), jnp.sin(ang)


def apply_rope(x, cos, sin):
    x2 = x.reshape(*x.shape[:-1], -1, 2).astype(jnp.float32)
    x0, x1 = x2[..., 0], x2[..., 1]
    out = jnp.stack([x0 * cos - x1 * sin, x0 * sin + x1 * cos], axis=-1)
    return out.reshape(x.shape).astype(x.dtype)


def dense_attention(q, k, v, scale):
    B, T, H, dk = q.shape
    nb = T // Q_BLOCK
    qb = q.reshape(B, nb, Q_BLOCK, H, dk).transpose(1, 0, 2, 3, 4)

    def block(qi):
        s = jnp.einsum('bqhd,bkhd->bhqk', qi, k).astype(jnp.float32) * scale
        p = jax.nn.softmax(s, axis=-1).astype(v.dtype)
        return jnp.einsum('bhqk,bkhd->bqhd', p, v)

    o = lax.map(block, qb)
    return o.transpose(1, 0, 2, 3, 4).reshape(B, T, H, v.shape[-1])


def gla_chunked(q, k, v, log_g, s0, include_diag):
    B, T, H, DK = q.shape
    DV = v.shape[-1]
    n = T // GLA_CHUNK

    def to_chunks(a):
        return a.reshape(B, n, GLA_CHUNK, H, a.shape[-1]).transpose(1, 0, 3, 2, 4)

    idx = jnp.arange(GLA_CHUNK)
    mask = (idx[:, None] >= idx[None, :]) if include_diag else (idx[:, None] > idx[None, :])

    def step(s, inp):
        qi, ki, vi, gi = inp
        b = jnp.cumsum(gi.astype(jnp.float32), axis=-2)
        diff = b[:, :, :, None, :] - b[:, :, None, :, :]
        decay = jnp.exp(jnp.where(mask[:, :, None], diff, -jnp.inf)).astype(qi.dtype)
        att = jnp.einsum('bhid,bhjd,bhijd->bhij', qi, ki, decay)
        o_intra = jnp.einsum('bhij,bhjv->bhiv', att, vi)
        o_inter = jnp.einsum('bhid,bhdv->bhiv', qi * jnp.exp(b).astype(qi.dtype), s)
        b_last = b[:, :, -1:, :]
        k_dec = ki * jnp.exp(b_last - b).astype(ki.dtype)
        s_new = s * jnp.exp(b_last[:, :, 0, :])[..., None].astype(s.dtype) + jnp.einsum('bhjd,bhjv->bhdv', k_dec, vi)
        return s_new, o_intra + o_inter

    s_fin, o = lax.scan(step, s0, (to_chunks(q), to_chunks(k), to_chunks(v), to_chunks(log_g)))
    return o.transpose(1, 0, 3, 2, 4).reshape(B, T, H, DV), s_fin


def gla_log_gate(lr, wg2, bg):
    return jax.nn.log_sigmoid((lr @ wg2 + bg).astype(jnp.float32)) / GLA_TAU


def gla_out(o, r, norm_g):
    B, T = o.shape[:2]
    return rms_norm(o, norm_g).reshape(B, T, GLA_V) * jax.nn.silu(r)


def even_project(h, w_in, wg2_f, bg_f, wg2_b, bg_b, q_norm_g, kv_norm_g, w_uq, w_ukv):
    B, T, _ = h.shape
    split_points = np.cumsum(EVEN_SIZES)[:-1].tolist()
    q_g, k_g, v_g, r_g, lr_f, lr_b, c_q, c_kv, k_r = jnp.split(h @ w_in, split_points, axis=-1)
    heads = lambda a, n: a.reshape(B, T, n, -1)
    gla = (heads(q_g, GLA_HEADS) * GLA_DK ** -0.5, heads(k_g, GLA_HEADS), heads(v_g, GLA_HEADS),
           heads(gla_log_gate(lr_f, wg2_f, bg_f), GLA_HEADS), heads(gla_log_gate(lr_b, wg2_b, bg_b), GLA_HEADS), r_g)
    q = heads(rms_norm(c_q, q_norm_g) @ w_uq, MLA_HEADS)
    kv = heads(rms_norm(c_kv, kv_norm_g) @ w_ukv, MLA_HEADS)
    mla = (q[..., :MLA_D_NOPE], q[..., MLA_D_NOPE:], kv[..., :MLA_D_NOPE], k_r, kv[..., MLA_D_NOPE:])
    return gla, mla


def even_mixer(hc, hl, cos, sin, w_in, wg2_f, bg_f, wg2_b, bg_b, gla_norm_g, q_norm_g, kv_norm_g,
               w_uq, w_ukv, w_out, with_ctx_out):
    B, S, _ = hl.shape
    args = (w_in, wg2_f, bg_f, wg2_b, bg_b, q_norm_g, kv_norm_g, w_uq, w_ukv)
    (gq_c, gk_c, gv_c, gf_c, gb_c, r_c), (qn_c, qr_c, kn_c, kr_c, v_c) = even_project(hc, *args)
    (gq_l, gk_l, gv_l, gf_l, gb_l, r_l), (qn_l, qr_l, kn_l, kr_l, v_l) = even_project(hl, *args)

    s0 = jnp.zeros((B, GLA_HEADS, GLA_DK, GLA_DV), hl.dtype)
    flip = lambda a: a[:, ::-1]
    o_cf, s_cf = gla_chunked(gq_c, gk_c, gv_c, gf_c, s0, True)
    o_cb, s_cb = gla_chunked(flip(gq_c), flip(gk_c), flip(gv_c), flip(gb_c), s0, False)
    o_lf, _ = gla_chunked(gq_l, gk_l, gv_l, gf_l, s_cf, True)
    o_lb, _ = gla_chunked(flip(gq_l), flip(gk_l), flip(gv_l), flip(gb_l), s_cb, False)
    gla_l = gla_out(o_lf + flip(o_lb), r_l, gla_norm_g)

    rope_shape = kn_l.shape[:-1] + (MLA_D_ROPE,)
    q_l = jnp.concatenate([qn_l, apply_rope(qr_l, cos[None, :, None], sin[None, :, None])], axis=-1)
    kr_l_rot = apply_rope(kr_l, cos[None], sin[None])
    k_l = jnp.concatenate([kn_l, jnp.broadcast_to(kr_l_rot[:, :, None], rope_shape)], axis=-1)
    k_c = jnp.concatenate([kn_c, jnp.broadcast_to(kr_c[:, :, None], kn_c.shape[:-1] + (MLA_D_ROPE,))], axis=-1)
    k_all = jnp.concatenate([k_c, k_l], axis=1)
    v_all = jnp.concatenate([v_c, v_l], axis=1)
    mla_l = dense_attention(q_l, k_all, v_all, MLA_SCALE).reshape(B, S, -1)

    yl = jnp.concatenate([gla_l, mla_l], axis=-1) @ w_out
    yc = None
    if with_ctx_out:
        Tc = hc.shape[1]
        gla_c = gla_out(o_cf + flip(o_cb), r_c, gla_norm_g)
        q_c = jnp.concatenate([qn_c, qr_c], axis=-1)
        mla_c = dense_attention(q_c, k_c, v_c, MLA_SCALE).reshape(B, Tc, -1)
        yc = jnp.concatenate([gla_c, mla_c], axis=-1) @ w_out
    return yc, yl


def neighbourhood_attention(q, k, v, k_ctx, v_ctx, rpb):
    B, S, H, d = q.shape
    rows = S // GRID_W
    kh = min(NA_KH, rows)
    scale = d ** -0.5
    qg = q.reshape(B, rows, GRID_W, H, d)
    kg = k.reshape(B, rows, GRID_W, H, d)
    vg = v.reshape(B, rows, GRID_W, H, d)
    col = jnp.arange(GRID_W)
    col_start = jnp.clip(col - NA_KW // 2, 0, GRID_W - NA_KW)
    col_idx = col_start[:, None] + jnp.arange(NA_KW)[None, :]
    bias_col = rpb[:, :, col_idx - col[:, None] + (NA_KW - 1)]

    def row_block(r):
        r_start = jnp.clip(r - kh // 2, 0, rows - kh)
        k_win = lax.dynamic_slice_in_dim(kg, r_start, kh, axis=1)[:, :, col_idx]
        v_win = lax.dynamic_slice_in_dim(vg, r_start, kh, axis=1)[:, :, col_idx]
        q_r = lax.dynamic_index_in_dim(qg, r, axis=1, keepdims=False)
        rel_row = r_start + jnp.arange(kh) - r + (NA_KH - 1)
        bias = jnp.take(bias_col, rel_row, axis=1).transpose(0, 2, 1, 3)
        s_nb = jnp.einsum('bchd,brcwhd->bhcrw', q_r, k_win).astype(jnp.float32) * scale + bias[None]
        s_cx = jnp.einsum('bchd,bkhd->bhck', q_r, k_ctx).astype(jnp.float32) * scale
        p = jax.nn.softmax(jnp.concatenate([s_nb.reshape(B, H, GRID_W, kh * NA_KW), s_cx], axis=-1), axis=-1)
        p = p.astype(v.dtype)
        p_nb = p[..., :kh * NA_KW].reshape(B, H, GRID_W, kh, NA_KW)
        p_cx = p[..., kh * NA_KW:]
        return (jnp.einsum('bhcrw,brcwhd->bchd', p_nb, v_win)
                + jnp.einsum('bhck,bkhd->bchd', p_cx, v_ctx))

    o = lax.map(row_block, jnp.arange(rows))
    return o.transpose(1, 0, 2, 3, 4).reshape(B, S, H, d)


def odd_mixer(hc, hl, w_in, rpb, w_out, with_ctx_out):
    def project(h):
        B, T, _ = h.shape
        q, k, v = jnp.split(h @ w_in, 3, axis=-1)
        return (q.reshape(B, T, NA_HEADS, NA_HEAD_DIM), k.reshape(B, T, NA_HEADS, NA_HEAD_DIM),
                v.reshape(B, T, NA_HEADS, NA_HEAD_DIM))

    B, S, _ = hl.shape
    q_c, k_c, v_c = project(hc)
    q_l, k_l, v_l = project(hl)
    yl = neighbourhood_attention(q_l, k_l, v_l, k_c, v_c, rpb).reshape(B, S, NA_WIDTH) @ w_out
    yc = None
    if with_ctx_out:
        o_c = dense_attention(q_c, k_c, v_c, NA_HEAD_DIM ** -0.5)
        yc = o_c.reshape(B, hc.shape[1], NA_WIDTH) @ w_out
    return yc, yl


def setup_inputs(seed: int = 0) -> dict:
    key = jax.random.key(seed)
    it = iter(list(jax.random.split(key, 32)))
    nrm = lambda shape, scale: jax.random.normal(next(it), shape, jnp.float32) * scale
    D = D_MODEL
    gate_base = jnp.tile(jnp.concatenate([jnp.zeros((2 * D,), jnp.float32), jnp.ones((D,), jnp.float32)]), 3)
    return {
        'x': nrm((BATCH, SEQ, D), 1.0),
        'c': nrm((BATCH, D), 1.0),
        'ctx': nrm((BATCH, CTX_LEN, D), 1.0),
        'c_ctx': nrm((D,), 1.0),
        'ada_w': nrm((DEPTH, D, 9 * D), 0.5 * D ** -0.5),
        'ada_b': gate_base + nrm((DEPTH, 9 * D), 0.02),
        'ffn1_w_in': nrm((DEPTH, D, 2 * D_FF), D ** -0.5),
        'ffn1_w_out': nrm((DEPTH, D_FF, D), BETA * D_FF ** -0.5),
        'ffn2_w_in': nrm((DEPTH, D, 2 * D_FF), D ** -0.5),
        'ffn2_w_out': nrm((DEPTH, D_FF, D), BETA * D_FF ** -0.5),
        'even_w_in': nrm((N_EVEN, D, sum(EVEN_SIZES)), D ** -0.5),
        'gla_wg2_f': nrm((N_EVEN, GLA_RANK, GLA_QK), GLA_RANK ** -0.5),
        'gla_bg_f': nrm((N_EVEN, GLA_QK), 0.5),
        'gla_wg2_b': nrm((N_EVEN, GLA_RANK, GLA_QK), GLA_RANK ** -0.5),
        'gla_bg_b': nrm((N_EVEN, GLA_QK), 0.5),
        'gla_norm_g': 1.0 + nrm((N_EVEN, GLA_DV), 0.02),
        'mla_q_norm_g': 1.0 + nrm((N_EVEN, MLA_D_CQ), 0.02),
        'mla_kv_norm_g': 1.0 + nrm((N_EVEN, MLA_D_CKV), 0.02),
        'mla_w_uq': nrm((N_EVEN, MLA_D_CQ, MLA_HEADS * (MLA_D_NOPE + MLA_D_ROPE)), MLA_D_CQ ** -0.5),
        'mla_w_ukv': nrm((N_EVEN, MLA_D_CKV, MLA_HEADS * (MLA_D_NOPE + MLA_D_V)), MLA_D_CKV ** -0.5),
        'even_w_out': nrm((N_EVEN, EVEN_OUT_IN, D), BETA * EVEN_OUT_IN ** -0.5),
        'na_w_in': nrm((N_ODD, D, 3 * NA_WIDTH), D ** -0.5),
        'na_rpb': nrm((N_ODD, NA_HEADS, 2 * NA_KH - 1, 2 * NA_KW - 1), 0.5),
        'na_w_out': nrm((N_ODD, NA_WIDTH, D), BETA * NA_WIDTH ** -0.5),
    }


def reference(x, c, ctx, c_ctx, ada_w, ada_b, ffn1_w_in, ffn1_w_out, ffn2_w_in, ffn2_w_out,
              even_w_in, gla_wg2_f, gla_bg_f, gla_wg2_b, gla_bg_b, gla_norm_g, mla_q_norm_g, mla_kv_norm_g,
              mla_w_uq, mla_w_ukv, even_w_out, na_w_in, na_rpb, na_w_out):
    S = x.shape[1]
    cos, sin = axial_rope(S)
    xl, xc = x, ctx
    for l in range(DEPTH):
        last = l == DEPTH - 1
        i = l // 2
        mod_l = jax.nn.silu(c) @ ada_w[l] + ada_b[l]
        mod_c = jax.nn.silu(c_ctx) @ ada_w[l] + ada_b[l]
        sh1, sc1, g1, sh2, sc2, g2, sh3, sc3, g3 = [m[:, None, :] for m in jnp.split(mod_l, 9, axis=-1)]
        csh1, csc1, cg1, csh2, csc2, cg2, csh3, csc3, cg3 = jnp.split(mod_c, 9)

        xl = post_norm(xl, 0.5 * g1 * swiglu(modulate(xl, sh1, sc1), ffn1_w_in[l], ffn1_w_out[l]))
        xc = post_norm(xc, 0.5 * cg1 * swiglu(modulate(xc, csh1, csc1), ffn1_w_in[l], ffn1_w_out[l]))

        hl = modulate(xl, sh2, sc2)
        hc = modulate(xc, csh2, csc2)
        if l % 2 == 0:
            yc, yl = even_mixer(hc, hl, cos, sin, even_w_in[i], gla_wg2_f[i], gla_bg_f[i], gla_wg2_b[i], gla_bg_b[i],
                                gla_norm_g[i], mla_q_norm_g[i], mla_kv_norm_g[i], mla_w_uq[i], mla_w_ukv[i],
                                even_w_out[i], not last)
        else:
            yc, yl = odd_mixer(hc, hl, na_w_in[i], na_rpb[i], na_w_out[i], not last)
        xl = post_norm(xl, g2 * yl)

        xl = post_norm(xl, 0.5 * g3 * swiglu(modulate(xl, sh3, sc3), ffn2_w_in[l], ffn2_w_out[l]))
        if not last:
            xc = post_norm(xc, cg2 * yc)
            xc = post_norm(xc, 0.5 * cg3 * swiglu(modulate(xc, csh3, csc3), ffn2_w_in[l], ffn2_w_out[l]))
    return xl
```

```cpp
#include <hip/hip_runtime.h>
#include <hip/hip_cooperative_groups.h>
#include <cstdio>
#include <cstdint>
namespace cg = cooperative_groups;
#ifndef DBG_HI
#define DBG_HI NPH
#endif
#ifndef DUP
#define DUP 0
#endif

#define LAS __attribute__((address_space(3)))
typedef unsigned short bf16_t;
typedef short bf16x8 __attribute__((ext_vector_type(8)));
typedef short s16x4 __attribute__((ext_vector_type(4)));
typedef float f32x4 __attribute__((ext_vector_type(4)));
typedef float f32x2 __attribute__((ext_vector_type(2)));
typedef float f32x16 __attribute__((ext_vector_type(16)));
typedef unsigned u32x4 __attribute__((ext_vector_type(4)));
typedef unsigned u32x2 __attribute__((ext_vector_type(2)));

constexpr int DM = 1024, NB = 4, SEQ = 8192, CTXL = 256, ML = NB * SEQ, MC = NB * CTXL, MR = ML + MC;
constexpr int DFF = 2816, PW = 2144, NCH = 132;
constexpr float LN_EPS = 1e-6f;
constexpr float ALPHA = 1.6817928305074290f;
constexpr int PC_Q = 0, PC_K = 256, PC_V = 512, PC_R = 1024, PC_LRF = 1536, PC_CQ = 1568, PC_CKV = 1952, PC_KR = 2080;

constexpr size_t MiB = 1u << 20;
constexpr size_t OFF_MOD = 0;
constexpr size_t OFF_PAR = 768 * 1024;
constexpr int PQ_QNG = 0, PQ_KVNG = 768, PQ_WG2F = 1024, PQ_BGF = 9216, PQ_WG2B = 9728, PQ_BGB = 17920, PQ_GLANG = 18432, PQ_RPB = 18688;
constexpr size_t OFF_BAR = 960 * 1024;
constexpr size_t OFF_ROPE = 1 * MiB;
constexpr size_t OFF_XC = 3 * MiB;
constexpr size_t OFF_W = 7 * MiB;
constexpr size_t WL_BYTES = 33 * MiB, W1OUT_O = 11 * MiB, W2IN_O = 16 * MiB + MiB / 2, W2OUT_O = 27 * MiB + MiB / 2;
constexpr size_t OFF_WE = OFF_W + 4 * WL_BYTES;
constexpr size_t WUQ_O = 4 * MiB + MiB / 2, WUKV_O = 5 * MiB + MiB / 4, WEO_O = 5 * MiB + MiB / 2;
constexpr size_t OFF_WO = OFF_WE + 16 * MiB;
constexpr size_t WNO_O = 6 * MiB;
constexpr size_t OFF_HB = OFF_WO + 16 * MiB;
constexpr size_t OFF_R = OFF_HB + 66 * MiB;
constexpr size_t R_SL = 139 * MiB, R_DEC = 205 * MiB, R_QB = 207 * MiB, R_KVB = 257 * MiB, R_END = 323 * MiB;
constexpr size_t R_YODD = 198 * MiB;
constexpr size_t R_PART = 270 * MiB;
constexpr size_t WS_END = OFF_R + R_END;

__device__ __forceinline__ int otid() { int t = threadIdx.x; asm volatile("" : "+v"(t)); return t; }
__device__ __forceinline__ int obid() { int b = blockIdx.x; asm volatile("" : "+s"(b)); return b; }
__device__ __forceinline__ unsigned char* optr(unsigned char* p) { size_t z = 0; asm volatile("" : "+s"(z)); return p + z; }

namespace pg8 {
constexpr int BM = 256, BK = 64, HALF = 128, HTB = HALF * BK * 2, STAGE_BYTES = 8 * HTB, NXCD = 8, WGM = 8;
__host__ __device__ __forceinline__ int lds_byte(int r, int c) { const int st = (r >> 4) * 2 + (c >> 5), rr = r & 15, cc = c & 31, ob = rr * 64 + cc * 2; return st * 1024 + (ob ^ (((ob >> 9) & 1) << 5)); }
__host__ __device__ __forceinline__ void stage_rc(int b, int& R, int& C) { const int st = b / 1024, sb = b % 1024, swz = sb ^ (((sb >> 9) & 1) << 5); R = (st >> 1) * 16 + swz / 64; C = (st & 1) * 32 + (swz % 64) / 2; }
__host__ __device__ __forceinline__ int perm32(int rho) { const int n = rho >> 4, i = rho & 15; return 8 * (i >> 2) + 4 * n + (i & 3); }
struct Unit { int pm, pn, kt0, nt, part; };
struct Gemm { const bf16_t* A; const bf16_t* Bt; int M, N, K, lda, ldb; };
struct StaticOrder {
    int nM, nN, nwg, G, c, ntk, nsplit, nextra;
    __device__ void init(int M, int N, int K, int G_, int c_, int split) { nN = N / BM; ntk = K / BK; nM = split ? 128 : M / BM; nsplit = split ? ntk / 4 : 0; nextra = 4 * nN * nsplit; nwg = nM * nN; G = G_; c = c_; }
    __device__ bool next(int i, Unit& u) const {
        long L = (long)i * G + c;
        if (L >= nwg) { L -= nwg; if (L >= nextra) return false; const int part = (int)L % nsplit, tile = (int)L / nsplit; u.pn = tile % nN; u.pm = 128 + tile / nN; u.kt0 = part * 4; u.nt = 4; u.part = part; return true; }
        int wgid = (int)L; { const int q = nwg / NXCD, r = nwg % NXCD, xcd = wgid % NXCD, off = wgid / NXCD; wgid = (xcd < r ? xcd * (q + 1) : r * (q + 1) + (xcd - r) * q) + off; }
        const int nig = WGM * nN, gid = wgid / nig, fm = gid * WGM, gsz = (nM - fm) < WGM ? (nM - fm) : WGM;
        u.pm = fm + ((wgid % nig) % gsz); u.pn = (wgid % nig) / gsz; u.kt0 = 0; u.nt = ntk; u.part = -1; return true;
    }
};
typedef __bf16 bf16x2_t __attribute__((ext_vector_type(2)));
__device__ __forceinline__ unsigned cvt_pk_bf16(float lo, float hi) { f32x2 v = {lo, hi}; bf16x2_t b = __builtin_convertvector(v, bf16x2_t); return __builtin_bit_cast(unsigned, b); }

struct EpiStore {
    static constexpr bool PERM = true;
    bf16_t* O; int ldc; int ncols; bf16_t* PART;
    __device__ __forceinline__ void operator()(const f32x4 (&acc)[2][2][4][2], const Unit& u, int wr, int wc, int fr, int fq) const {
        int row0 = u.pm * BM + wr * 64 + fr; const int col0 = u.pn * BM + wc * 32 + 8 * fq; bf16_t* Ob = O;
        if (u.part >= 0) { Ob = PART + (size_t)u.part * 1024 * 1024; row0 -= 128 * BM; }
#pragma unroll
        for (int ai = 0; ai < 2; ++ai)
#pragma unroll
            for (int m = 0; m < 4; ++m) { bf16_t* rowp = Ob + (size_t)(row0 + ai * HALF + m * 16) * ldc + col0;
#pragma unroll
                for (int bj = 0; bj < 2; ++bj) { const f32x4 v0 = acc[ai][bj][m][0], v1 = acc[ai][bj][m][1];
                    u32x4 w; w.x = cvt_pk_bf16(v0[0], v0[1]); w.y = cvt_pk_bf16(v0[2], v0[3]); w.z = cvt_pk_bf16(v1[0], v1[1]); w.w = cvt_pk_bf16(v1[2], v1[3]);
                    if (col0 + bj * HALF < ncols) *(u32x4*)(rowp + bj * HALF) = w; } }
    }
};
__device__ __forceinline__ float silu_f(float x) { return x * __builtin_amdgcn_rcpf(1.0f + __builtin_amdgcn_exp2f(-1.4426950408889634f * x)); }
struct EpiSwiglu {
    static constexpr bool PERM = true;
    bf16_t* O; int ldc;
    __device__ __forceinline__ void operator()(const f32x4 (&acc)[2][2][4][2], const Unit& u, int wr, int wc, int fr, int fq) const {
        const int row0 = u.pm * BM + wr * 64 + fr; const int col0 = u.pn * HALF + wc * 32 + 8 * fq;
#pragma unroll
        for (int ai = 0; ai < 2; ++ai)
#pragma unroll
            for (int m = 0; m < 4; ++m) { bf16_t* rowp = O + (size_t)(row0 + ai * HALF + m * 16) * ldc + col0;
                const f32x4 g0 = acc[ai][0][m][0], g1 = acc[ai][0][m][1], u0 = acc[ai][1][m][0], u1 = acc[ai][1][m][1];
                u32x4 w; w.x = cvt_pk_bf16(silu_f(g0[0]) * u0[0], silu_f(g0[1]) * u0[1]); w.y = cvt_pk_bf16(silu_f(g0[2]) * u0[2], silu_f(g0[3]) * u0[3]);
                w.z = cvt_pk_bf16(silu_f(g1[0]) * u1[0], silu_f(g1[1]) * u1[1]); w.w = cvt_pk_bf16(silu_f(g1[2]) * u1[2], silu_f(g1[3]) * u1[3]);
                *(u32x4*)rowp = w; }
    }
};

template <class Epi>
__device__ __forceinline__ void gemm_phase(LAS unsigned char* lds, const Gemm g, const StaticOrder& S, const Epi& E) {
    const int tid = otid(), wid = __builtin_amdgcn_readfirstlane(tid >> 6), lane = tid & 63, wr = wid >> 2, wc = wid & 3, fr = lane & 15, fq = lane >> 4;
    unsigned voffA[2], voffB[2];
#pragma unroll
    for (int i = 0; i < 2; ++i) { int R, C; stage_rc(tid * 16 + i * 8192, R, C); const int Rb = Epi::PERM ? ((R & ~31) + perm32(R & 31)) : R;
        voffA[i] = (unsigned)(R * g.lda + C) * 2u; voffB[i] = (unsigned)(Rb * g.ldb + C) * 2u; }
    const size_t kstep = (size_t)(BK * 2);
    const size_t hsA = (size_t)HALF * g.lda * 2, hsB = (size_t)HALF * g.ldb * 2;
    const size_t tsA = 2 * hsA, tsB = 2 * hsB;
    const unsigned ldsw = (unsigned)wid * 1024u;
    const int aoff = lds_byte(wr * 64 + fr, fq * 8), boff = lds_byte(wc * 32 + fr, fq * 8);
#define PG8_SA(b, h) (((b) * 2 + (h)) * HTB)
#define PG8_SB(b, h) ((4 + (b) * 2 + (h)) * HTB)
#define PG8_STAGE(bufoff, gbase, voff) do { _Pragma("unroll") for (int _i = 0; _i < 2; ++_i) \
        __builtin_amdgcn_global_load_lds((const unsigned*)((const char*)(gbase) + (voff)[_i]), (LAS unsigned*)(lds + (bufoff) + ldsw + _i * 8192), 16, 0, 0); } while (0)
#define PG8_LDA(dst, b, h) do { _Pragma("unroll") for (int m = 0; m < 4; ++m) _Pragma("unroll") for (int k = 0; k < 2; ++k) dst[m][k] = *(const LAS bf16x8*)(lds + PG8_SA(b, h) + aoff + m * 2048 + k * 1024); } while (0)
#define PG8_LDB(dst, b, h) do { _Pragma("unroll") for (int n = 0; n < 2; ++n) _Pragma("unroll") for (int k = 0; k < 2; ++k) dst[n][k] = *(const LAS bf16x8*)(lds + PG8_SB(b, h) + boff + n * 2048 + k * 1024); } while (0)
#define PG8_MMA(ai, bj, At, Bt) do { __builtin_amdgcn_s_setprio(1); _Pragma("unroll") for (int m = 0; m < 4; ++m) _Pragma("unroll") for (int n = 0; n < 2; ++n) _Pragma("unroll") for (int k = 0; k < 2; ++k) \
        acc[ai][bj][m][n] = __builtin_amdgcn_mfma_f32_16x16x32_bf16(Bt[n][k], At[m][k], acc[ai][bj][m][n], 0, 0, 0); __builtin_amdgcn_s_setprio(0); } while (0)
#define PG8_WAIT_V(n) asm volatile("s_waitcnt vmcnt(" #n ")" ::: "memory")
#define PG8_WAIT_L(n) asm volatile("s_waitcnt lgkmcnt(" #n ")" ::: "memory")
#define PG8_BAR __builtin_amdgcn_s_barrier()
#define PG8_SCHED __builtin_amdgcn_sched_barrier(0)
    Unit cur, nxt; int ui = 0;
    if (!S.next(0, cur)) return;
    f32x4 acc[2][2][4][2];
#pragma unroll
    for (int a = 0; a < 2; ++a)
#pragma unroll
        for (int b = 0; b < 2; ++b)
#pragma unroll
            for (int m = 0; m < 4; ++m)
#pragma unroll
                for (int n = 0; n < 2; ++n) acc[a][b][m][n] = (f32x4){0.f, 0.f, 0.f, 0.f};
    bf16x8 At[4][2], B0[2][2], B1[2][2];
    const char* cA = (const char*)g.A + (size_t)cur.pm * tsA + (size_t)cur.kt0 * kstep; const char* cB = (const char*)g.Bt + (size_t)cur.pn * tsB + (size_t)cur.kt0 * kstep;
    PG8_STAGE(PG8_SB(0, 0), cB, voffB); PG8_STAGE(PG8_SB(0, 1), cB + hsB, voffB); PG8_STAGE(PG8_SA(0, 0), cA, voffA); PG8_STAGE(PG8_SA(0, 1), cA + hsA, voffA);
    if (wr == 1) PG8_BAR;
    PG8_WAIT_V(2); PG8_BAR;
    PG8_STAGE(PG8_SB(1, 0), cB + kstep, voffB); PG8_STAGE(PG8_SA(1, 0), cA + kstep, voffA); PG8_STAGE(PG8_SB(1, 1), cB + hsB + kstep, voffB);
    PG8_WAIT_V(6); PG8_BAR;
    for (;;) {
        const bool has_next = S.next(ui + 1, nxt);
        const char* nA = has_next ? (const char*)g.A + (size_t)nxt.pm * tsA + (size_t)nxt.kt0 * kstep : cA; const char* nB = has_next ? (const char*)g.Bt + (size_t)nxt.pn * tsB + (size_t)nxt.kt0 * kstep : cB;
        const int nt = cur.nt;
        for (int t = 0; t < nt; t += 2) {
            const bool last = (t == nt - 2);
            const char* a1 = cA + (size_t)(t + 1) * kstep;
            const char* a2 = last ? nA : cA + (size_t)(t + 2) * kstep; const char* b2 = last ? nB : cB + (size_t)(t + 2) * kstep;
            const char* a3 = a2 + kstep; const char* b3 = b2 + kstep;
            PG8_LDB(B0, 0, 0); PG8_LDB(B1, 0, 1); PG8_SCHED; PG8_LDA(At, 0, 0); PG8_STAGE(PG8_SA(1, 1), a1 + hsA, voffA);
            PG8_WAIT_V(8); PG8_WAIT_L(0); PG8_BAR; PG8_MMA(0, 0, At, B0); PG8_MMA(0, 1, At, B1); PG8_BAR; PG8_SCHED;
            PG8_LDA(At, 0, 1); PG8_STAGE(PG8_SB(0, 0), b2, voffB); PG8_STAGE(PG8_SB(0, 1), b2 + hsB, voffB); PG8_STAGE(PG8_SA(0, 0), a2, voffA);
            PG8_WAIT_V(8); PG8_WAIT_L(0); PG8_BAR; PG8_MMA(1, 0, At, B0); PG8_MMA(1, 1, At, B1); PG8_BAR; PG8_SCHED;
            PG8_LDB(B0, 1, 0); PG8_LDB(B1, 1, 1); PG8_SCHED; PG8_LDA(At, 1, 0); PG8_STAGE(PG8_SA(0, 1), a2 + hsA, voffA);
            PG8_WAIT_V(8); PG8_WAIT_L(0); PG8_BAR; PG8_MMA(0, 0, At, B0); PG8_MMA(0, 1, At, B1); PG8_BAR; PG8_SCHED;
            PG8_LDA(At, 1, 1); PG8_STAGE(PG8_SB(1, 0), b3, voffB); PG8_STAGE(PG8_SB(1, 1), b3 + hsB, voffB); PG8_STAGE(PG8_SA(1, 0), a3, voffA);
            PG8_WAIT_V(8); PG8_WAIT_L(0); PG8_BAR; PG8_MMA(1, 0, At, B0); PG8_MMA(1, 1, At, B1); PG8_BAR; PG8_SCHED;
        }
        if (wr == 0) PG8_BAR;
        E(acc, cur, wr, wc, fr, fq);
        if (!has_next) break;
#pragma unroll
        for (int a = 0; a < 2; ++a)
#pragma unroll
            for (int b = 0; b < 2; ++b)
#pragma unroll
                for (int m = 0; m < 4; ++m)
#pragma unroll
                    for (int n = 0; n < 2; ++n) acc[a][b][m][n] = (f32x4){0.f, 0.f, 0.f, 0.f};
        cur = nxt; cA = nA; cB = nB; ++ui;
        if (wr == 1) PG8_BAR;
    }
    PG8_WAIT_V(0);
    PG8_BAR;
#undef PG8_SA
#undef PG8_SB
#undef PG8_STAGE
#undef PG8_LDA
#undef PG8_LDB
#undef PG8_MMA
#undef PG8_WAIT_V
#undef PG8_WAIT_L
#undef PG8_BAR
#undef PG8_SCHED
}
}

__device__ __forceinline__ float bf2f(unsigned short h) { return __uint_as_float((unsigned)h << 16); }
__device__ __forceinline__ unsigned pk2(float lo, float hi) { return pg8::cvt_pk_bf16(lo, hi); }
__device__ __forceinline__ bf16_t f2bf(float f) { return (bf16_t)(pk2(f, 0.f) & 0xffffu); }
__device__ __forceinline__ float wave_sum(float v) {
#pragma unroll
    for (int o = 1; o < 64; o <<= 1) v += __shfl_xor(v, o);
    return v;
}
__device__ __forceinline__ int crow(int r, int hi) { return (r & 3) + 8 * (r >> 2) + 4 * hi; }
__device__ __forceinline__ float logsig16(float x) { return (fminf(x, 0.f) - __logf(1.0f + __expf(-fabsf(x)))) * 0.0625f; }

namespace fa {
#define SBAR() __builtin_amdgcn_sched_barrier(0)
#define KOFF(PITCH, row, colB) ((row) * (PITCH) + ((colB) ^ ((((row) >> 1) & 7) << 4)))
struct Args {
    const bf16_t* Q; int ldq;
    const bf16_t* K1; int ldk1; const bf16_t* K2; int ldk2; const bf16_t* V; int ldv;
    bf16_t* O; int ldo;
    int ctxrow0, latrow0, NT;
    float C, thr;
    const f32x2* rope; int pos0;
    const float* rpb; int masked; int r0, krow0;
};
__device__ __forceinline__ void partialSM(f32x16& p0, f32x16& p1, float& m_reg, float& mn, float& alpha, float C, float thr) {
    float pmax = p0[0];
#pragma unroll
    for (int r = 1; r < 16; ++r) pmax = fmaxf(pmax, p0[r]);
#pragma unroll
    for (int r = 0; r < 16; ++r) pmax = fmaxf(pmax, p1[r]);
    { auto rr = __builtin_amdgcn_permlane32_swap(__float_as_uint(pmax), __float_as_uint(pmax), false, false);
      pmax = fmaxf(__uint_as_float(rr[0]), __uint_as_float(rr[1])); }
    if (__builtin_expect(__all(pmax - m_reg <= thr), 1)) { mn = m_reg; alpha = 1.f; }
    else { mn = fmaxf(m_reg, pmax); alpha = __builtin_amdgcn_exp2f((m_reg - mn) * C); m_reg = mn; }
    const float mnC = -mn * C;
#pragma unroll
    for (int r = 0; r < 16; ++r) p0[r] = fmaf(p0[r], C, mnC);
#pragma unroll
    for (int r = 0; r < 16; ++r) p1[r] = fmaf(p1[r], C, mnC);
#pragma unroll
    for (int r = 0; r < 16; ++r) p0[r] = __builtin_amdgcn_exp2f(p0[r]);
}
__device__ __forceinline__ void finishSM(f32x16& p0, f32x16& p1, float alpha, float& l_reg, bf16x8& pa0, bf16x8& pa1, bf16x8& pa2, bf16x8& pa3) {
#pragma unroll
    for (int r = 0; r < 16; ++r) p1[r] = __builtin_amdgcn_exp2f(p1[r]);
    float ps = 0;
#pragma unroll
    for (int r = 0; r < 16; ++r) ps += p0[r];
#pragma unroll
    for (int r = 0; r < 16; ++r) ps += p1[r];
    { auto rr = __builtin_amdgcn_permlane32_swap(__float_as_uint(ps), __float_as_uint(ps), false, false);
      ps = __uint_as_float(rr[0]) + __uint_as_float(rr[1]); }
    l_reg = l_reg * alpha + ps;
#define PK4(P, BASE, OUT) do { unsigned a0 = pk2(P[BASE + 0], P[BASE + 1]), a1 = pk2(P[BASE + 2], P[BASE + 3]);   \
    unsigned b0 = pk2(P[BASE + 4], P[BASE + 5]), b1 = pk2(P[BASE + 6], P[BASE + 7]);                              \
    auto r0 = __builtin_amdgcn_permlane32_swap(a0, b0, false, false); auto r1 = __builtin_amdgcn_permlane32_swap(a1, b1, false, false); \
    u32x4 w = {r0[0], r1[0], r0[1], r1[1]}; OUT = *reinterpret_cast<bf16x8*>(&w); } while (0)
    PK4(p0, 0, pa0); PK4(p0, 8, pa1); PK4(p1, 0, pa2); PK4(p1, 8, pa3);
#undef PK4
}
template <int DQK> __device__ __forceinline__ void qkt(f32x16& p0, f32x16& p1, const char* Ks, const bf16x8* qr, int r32, int hi) {
    constexpr int NQ = DQK / 16, PF = 2;
    p0 = f32x16{}; p1 = f32x16{};
    bf16x8 kb0[NQ], kb1[NQ];
#define KRD(d) do { const int cb_ = ((d) * 16 + hi * 8) * 2; kb0[d] = *reinterpret_cast<const bf16x8*>(Ks + KOFF(DQK * 2, r32, cb_)); kb1[d] = *reinterpret_cast<const bf16x8*>(Ks + KOFF(DQK * 2, 32 + r32, cb_)); } while (0)
#pragma unroll
    for (int d = 0; d < PF && d < NQ; ++d) KRD(d);
    SBAR();
#pragma unroll
    for (int d0 = 0; d0 < NQ; ++d0) {
        if (d0 + PF < NQ) KRD(d0 + PF);
        SBAR();
        p0 = __builtin_amdgcn_mfma_f32_32x32x16_bf16(kb0[d0], qr[d0], p0, 0, 0, 0);
        p1 = __builtin_amdgcn_mfma_f32_32x32x16_bf16(kb1[d0], qr[d0], p1, 0, 0, 0);
        SBAR();
    }
#undef KRD
}
template <int NCB> __device__ __forceinline__ int v_st(int k, int c) { const int kk = (k & ~0xC) | ((k & 4) << 1) | ((k & 8) >> 1); return ((kk >> 3) * NCB + (c >> 5)) * 512 + ((kk & 7) * 32 + (c & 31)) * 2; }
__device__ __forceinline__ int v_rd_base(int lane) { return ((lane & 3) << 3) | (((lane >> 2) & 3) << 6) | (((lane >> 4) & 1) << 5) | (((lane >> 5) & 1) << 8); }
template <int OFF> __device__ __forceinline__ s16x4 tr_read(int vb) {
    s16x4 r; asm volatile("ds_read_b64_tr_b16 %0, %1 offset:%2" : "=&v"(r) : "v"(vb), "i"(OFF) : "memory"); return r;
}
template <int D0, int NCB> __device__ __forceinline__ void pv_one(f32x16& od, int vb, bf16x8 pa0, bf16x8 pa1, bf16x8 pa2, bf16x8 pa3) {
    constexpr int KS = NCB * 1024, HF = NCB * 512, B = D0 * 512;
    const s16x4 l0 = tr_read<B>(vb), h0 = tr_read<B + HF>(vb), l1 = tr_read<B + KS>(vb), h1 = tr_read<B + KS + HF>(vb);
    const s16x4 l2 = tr_read<B + 2 * KS>(vb), h2 = tr_read<B + 2 * KS + HF>(vb), l3 = tr_read<B + 3 * KS>(vb), h3 = tr_read<B + 3 * KS + HF>(vb);
    asm volatile("s_waitcnt lgkmcnt(0)" ::: "memory"); SBAR();
#define PK(L, H) (bf16x8){L[0], L[1], L[2], L[3], H[0], H[1], H[2], H[3]}
    od = __builtin_amdgcn_mfma_f32_32x32x16_bf16(pa0, PK(l0, h0), od, 0, 0, 0);
    od = __builtin_amdgcn_mfma_f32_32x32x16_bf16(pa1, PK(l1, h1), od, 0, 0, 0);
    od = __builtin_amdgcn_mfma_f32_32x32x16_bf16(pa2, PK(l2, h2), od, 0, 0, 0);
    od = __builtin_amdgcn_mfma_f32_32x32x16_bf16(pa3, PK(l3, h3), od, 0, 0, 0);
#undef PK
}
template <int DV> __device__ __forceinline__ void pv_all(f32x16* o, int vb, bf16x8 pa0, bf16x8 pa1, bf16x8 pa2, bf16x8 pa3) {
    constexpr int NCB = DV / 32;
    pv_one<0, NCB>(o[0], vb, pa0, pa1, pa2, pa3); pv_one<1, NCB>(o[1], vb, pa0, pa1, pa2, pa3);
    if constexpr (DV == 128) { pv_one<2, NCB>(o[2], vb, pa0, pa1, pa2, pa3); pv_one<3, NCB>(o[3], vb, pa0, pa1, pa2, pa3); }
}
__device__ __forceinline__ void na_mask(f32x16& p0, f32x16& p1, const float* tr, bool rowvalid, int cs, int hi) {
    if (!rowvalid) {
#pragma unroll
        for (int r = 0; r < 16; ++r) { p0[r] = -1e30f; p1[r] = -1e30f; }
    } else {
#pragma unroll
        for (int r = 0; r < 16; ++r) { const int kc0 = (r & 3) + 8 * (r >> 2); const int kc = kc0 + 4 * hi;
            const bool v0 = (unsigned)(kc - cs) < 16u, v1 = (unsigned)(kc + 32 - cs) < 16u;
            const float b0 = tr[kc0], b1 = tr[kc0 + 32];
            p0[r] = v0 ? p0[r] + b0 : -1e30f; p1[r] = v1 ? p1[r] + b1 : -1e30f; }
    }
}

template <int DQK, int DV, bool NA>
__device__ __forceinline__ void flash_unit(char* lds, const Args& A) {
    constexpr int NQ = DQK / 16, NO = DV / 32, NCB = DV / 32, KP = DQK * 2, SHM_K = 64 * KP, SHM_V = 64 * DV * 2;
    constexpr int KSL = DQK / 8, NKS = 64 * KSL / 512, VSL = DV / 8, NVS = 64 * VSL / 512, W1S = (DQK == 192 ? 16 : 8);
    const int tid = otid(), wid = tid >> 6, lane = tid & 63, r32 = lane & 31, hi = lane >> 5;
    char* V_lds = lds; char* K_lds = lds + 2 * SHM_V;
    float* wsf = (float*)(lds + 2 * SHM_V + 2 * SHM_K) + wid * 64; float* li_l = wsf; float* al_l = wsf + 32;
    float* tab = (float*)(lds + 2 * SHM_V + 2 * SHM_K + 2048);
    __syncthreads();
    if (NA && A.masked) { for (int i = tid; i < 465; i += 512) tab[64 + i] = A.rpb[i] * 8.f; }
    float m_reg = -1e30f, l_reg = 0; f32x16 o[NO]; bf16x8 qr[NQ];
#pragma unroll
    for (int d = 0; d < NO; ++d) o[d] = f32x16{};
    const bf16_t* Qw = A.Q + (long)(wid * 32 + r32) * A.ldq + hi * 8;
#pragma unroll
    for (int d0 = 0; d0 < NQ; ++d0) qr[d0] = *reinterpret_cast<const bf16x8*>(Qw + d0 * 16);
    if constexpr (!NA) {
        if (A.rope) {
            const f32x2* rt = A.rope + (long)(A.pos0 + wid * 32 + r32) * 32 + hi * 4;
#pragma unroll
            for (int d0 = 8; d0 < 12; ++d0) { bf16x8 v = qr[d0]; u32x4 w;
#pragma unroll
                for (int p = 0; p < 4; ++p) { const f32x2 cs = rt[(d0 - 8) * 8 + p]; const float x0 = bf2f((unsigned short)v[2 * p]), x1 = bf2f((unsigned short)v[2 * p + 1]);
                    w[p] = pk2(x0 * cs.x - x1 * cs.y, x0 * cs.y + x1 * cs.x); }
                qr[d0] = *reinterpret_cast<bf16x8*>(&w); }
        }
    }
    const int qgrow = A.r0 + (wid >> 1), rs = min(max(qgrow - 4, 0), 120), qc = (wid & 1) * 32 + r32, cs = min(max(qc - 8, 0), 48);
    const float* tabl = tab + 64 + 15 - qc + 4 * hi;
    const int vb0 = (int)(uintptr_t)V_lds + v_rd_base(lane);
    LAS unsigned char* Ll = (LAS unsigned char*)lds; const int widu = __builtin_amdgcn_readfirstlane(wid);
#define G0(j) ((j) < 4 ? A.ctxrow0 + 64 * (j) : A.latrow0 + 64 * ((j) - 4))
#define DMA(jt, b) do { const int g0_ = G0(jt); \
    _Pragma("unroll") for (int i = 0; i < NKS; ++i) { const int s_ = tid + 512 * i, row = s_ / KSL, c = (s_ % KSL) ^ ((row >> 1) & 7); const bf16_t* p_; \
        if (DQK == 192 && c >= W1S) p_ = A.K2 + (long)(g0_ + row) * A.ldk2 + (c - W1S) * 8; else p_ = A.K1 + (long)(g0_ + row) * A.ldk1 + c * 8; \
        __builtin_amdgcn_global_load_lds((const unsigned*)p_, (LAS unsigned*)(Ll + 2 * SHM_V + (b) * SHM_K + (i * 512 + widu * 64) * 16), 16, 0, 0); } \
    _Pragma("unroll") for (int i = 0; i < NVS; ++i) { const int off_ = (tid + 512 * i) * 16, st_ = off_ >> 9, wi_ = off_ & 511, kk_ = (st_ / NCB) * 8 + (wi_ >> 6); \
        const int k_ = (kk_ & ~0xC) | ((kk_ & 4) << 1) | ((kk_ & 8) >> 1), c_ = (st_ % NCB) * 32 + ((wi_ & 63) >> 1); \
        __builtin_amdgcn_global_load_lds((const unsigned*)(A.V + (long)(g0_ + k_) * A.ldv + c_), (LAS unsigned*)(Ll + (b) * SHM_V + (i * 512 + widu * 64) * 16), 16, 0, 0); } } while (0)
#define SWAIT() asm volatile("s_waitcnt vmcnt(0)" ::: "memory")
#define RESC(a) do { if (__any((a) < 1.f)) { if (hi == 0) al_l[r32] = (a); asm volatile("s_waitcnt lgkmcnt(0)" ::: "memory"); \
    _Pragma("unroll") for (int d = 0; d < NO; ++d) _Pragma("unroll") for (int r = 0; r < 16; ++r) o[d][r] *= al_l[crow(r, hi)]; } } while (0)
#define NAMASK(P0, P1, jt) do { if (NA) { if (A.masked && (jt) >= 4) { const int kr_ = A.krow0 + (jt) - 4; na_mask(P0, P1, tabl + (kr_ - qgrow + 7) * 31, (kr_ >= rs && kr_ < rs + 8), cs, hi); } } } while (0)
    f32x16 p0, p1; float mn, al; bf16x8 pa0, pa1, pa2, pa3; const int NT = A.NT;
    DMA(0, 0); SWAIT(); __syncthreads();
    for (int j = 0; j < NT; ++j) {
        const int buf = j & 1;
        if (j + 1 < NT) DMA(j + 1, buf ^ 1);
        bool act = true;
        if (NA) { if (A.masked && j >= 4) { const int kr_ = A.krow0 + j - 4; act = (kr_ >= rs && kr_ < rs + 8); } }
        if (act) {
        SBAR(); qkt<DQK>(p0, p1, K_lds + buf * SHM_K, qr, r32, hi); NAMASK(p0, p1, j);
        partialSM(p0, p1, m_reg, mn, al, A.C, A.thr);
        finishSM(p0, p1, al, l_reg, pa0, pa1, pa2, pa3); RESC(al); SBAR();
        pv_all<DV>(o, vb0 + buf * SHM_V, pa0, pa1, pa2, pa3);
        }
        SWAIT();
        __syncthreads();
    }
    if (hi == 0) li_l[r32] = l_reg; asm volatile("s_waitcnt lgkmcnt(0)" ::: "memory");
    float rli[16];
#pragma unroll
    for (int r = 0; r < 16; ++r) rli[r] = __builtin_amdgcn_rcpf(li_l[crow(r, hi)]);
    bf16_t* Ow = A.O + (long)(wid * 32) * A.ldo;
#pragma unroll
    for (int r = 0; r < 16; ++r) { const int orow = crow(r, hi);
#pragma unroll
        for (int d0 = 0; d0 < NO; ++d0) Ow[(long)orow * A.ldo + d0 * 32 + r32] = f2bf(o[d0][r] * rli[r]); }
#undef G0
#undef DMA
#undef SWAIT
#undef RESC
#undef NAMASK
}
}

struct KArgs { const float* in[24]; float* out; unsigned char* ws; int lo, hi; };
enum { I_X = 0, I_C, I_CTX, I_CCTX, I_ADAW, I_ADAB, I_F1IN, I_F1OUT, I_F2IN, I_F2OUT, I_EWIN, I_WG2F, I_BGF, I_WG2B, I_BGB, I_GLANG, I_QNG, I_KVNG, I_WUQ, I_WUKV, I_EWOUT, I_NWIN, I_RPB, I_NWOUT };

__device__ __forceinline__ void transpose_item(const float* W, int K, int N, bf16_t* WT, int swiglu, LAS float* scr, int item, int lane) {
    const int nblk = N / 32, kb = item / nblk, nb = item % nblk, k0 = 64 * kb, n0 = 32 * nb;
    int rbase = n0;
    if (swiglu) { const int half = N / 2; const int up = n0 >= half; const int nn = up ? n0 - half : n0; rbase = (nn >> 7) * 256 + up * 128 + (nn & 127); }
    { float tv[32];
#pragma unroll
      for (int i = 0; i < 32; ++i) tv[i] = W[(size_t)(k0 + 2 * i + (lane >> 5)) * N + n0 + (lane & 31)];
#pragma unroll
      for (int i = 0; i < 32; ++i) scr[(2 * i + (lane >> 5)) * 33 + (lane & 31)] = tv[i]; }
    asm volatile("s_waitcnt lgkmcnt(0)" ::: "memory");
    const int c = lane & 7;
#pragma unroll
    for (int j = 0; j < 4; ++j) { const int n = (lane >> 3) + 8 * j; const LAS float* s = scr + (8 * c) * 33 + n;
        u32x4 o; o.x = pk2(s[0 * 33], s[1 * 33]); o.y = pk2(s[2 * 33], s[3 * 33]); o.z = pk2(s[4 * 33], s[5 * 33]); o.w = pk2(s[6 * 33], s[7 * 33]);
        *(u32x4*)(WT + (size_t)(rbase + n) * K + k0 + 8 * c) = o; }
    asm volatile("s_waitcnt lgkmcnt(0)" ::: "memory");
}

__device__ __forceinline__ void convert_layer(const KArgs& a, int l, int gw, int NGW, LAS float* scr, int lane) {
    unsigned char* ws = optr(a.ws);
    constexpr int I_IN = 16 * 176, I_OUT = 44 * 32, I_L = 2 * (I_IN + I_OUT);
    constexpr int I_EIN = 16 * 67, I_UQ = 6 * 24, I_UKV = 2 * 32, I_SQ = 16 * 32, I_E = I_EIN + I_UQ + I_UKV + I_SQ;
    constexpr int I_NIN = 16 * 96, I_O = I_NIN + I_SQ;
    const int i = l >> 1; const int nit = I_L + ((l & 1) ? I_O : I_E);
    unsigned char* wl = ws + OFF_W + (size_t)l * WL_BYTES; unsigned char* we = ws + OFF_WE + (size_t)i * 8 * MiB; unsigned char* wo = ws + OFF_WO + (size_t)i * 8 * MiB;
    for (int it = gw; it < nit; it += NGW) {
        int r = it;
        if (r < I_L) {
            if (r < I_IN) { transpose_item(a.in[I_F1IN] + (size_t)l * DM * 2 * DFF, DM, 2 * DFF, (bf16_t*)wl, 1, scr, r, lane); continue; } r -= I_IN;
            if (r < I_OUT) { transpose_item(a.in[I_F1OUT] + (size_t)l * DFF * DM, DFF, DM, (bf16_t*)(wl + W1OUT_O), 0, scr, r, lane); continue; } r -= I_OUT;
            if (r < I_IN) { transpose_item(a.in[I_F2IN] + (size_t)l * DM * 2 * DFF, DM, 2 * DFF, (bf16_t*)(wl + W2IN_O), 1, scr, r, lane); continue; } r -= I_IN;
            transpose_item(a.in[I_F2OUT] + (size_t)l * DFF * DM, DFF, DM, (bf16_t*)(wl + W2OUT_O), 0, scr, r, lane); continue; }
        r -= I_L;
        if (!(l & 1)) {
            if (r < I_EIN) { transpose_item(a.in[I_EWIN] + (size_t)i * DM * PW, DM, PW, (bf16_t*)we, 0, scr, r, lane); continue; } r -= I_EIN;
            if (r < I_UQ) { transpose_item(a.in[I_WUQ] + (size_t)i * 384 * 768, 384, 768, (bf16_t*)(we + WUQ_O), 0, scr, r, lane); continue; } r -= I_UQ;
            if (r < I_UKV) { transpose_item(a.in[I_WUKV] + (size_t)i * 128 * 1024, 128, 1024, (bf16_t*)(we + WUKV_O), 0, scr, r, lane); continue; } r -= I_UKV;
            transpose_item(a.in[I_EWOUT] + (size_t)i * DM * DM, DM, DM, (bf16_t*)(we + WEO_O), 0, scr, r, lane); }
        else {
            if (r < I_NIN) { transpose_item(a.in[I_NWIN] + (size_t)i * DM * 3072, DM, 3072, (bf16_t*)wo, 0, scr, r, lane); continue; } r -= I_NIN;
            transpose_item(a.in[I_NWOUT] + (size_t)i * DM * DM, DM, DM, (bf16_t*)(wo + WNO_O), 0, scr, r, lane); }
    }
}

__device__ __forceinline__ void phase_prep(const KArgs& a, unsigned char* lds_g) {
    unsigned char* wsq = optr(a.ws);
    LAS unsigned char* lds = (LAS unsigned char*)lds_g;
    const int tid = otid(), lane = tid & 63, wave = tid >> 6, G = gridDim.x;
    unsigned char* ws = wsq;
    convert_layer(a, 0, obid() * 8 + wave, G * 8, (LAS float*)(lds + wave * 16384), lane);
    {
        float* par = (float*)(ws + OFF_PAR); const int g0 = obid() * 512 + tid, gs = G * 512;
        for (int i = g0; i < 768; i += gs) par[PQ_QNG + i] = a.in[I_QNG][i];
        for (int i = g0; i < 256; i += gs) { par[PQ_KVNG + i] = a.in[I_KVNG][i]; par[PQ_GLANG + i] = a.in[I_GLANG][i]; }
        for (int i = g0; i < 8192; i += gs) { par[PQ_WG2F + i] = a.in[I_WG2F][i]; par[PQ_WG2B + i] = a.in[I_WG2B][i]; }
        for (int i = g0; i < 512; i += gs) { par[PQ_BGF + i] = a.in[I_BGF][i]; par[PQ_BGB + i] = a.in[I_BGB][i]; }
        for (int i = g0; i < 14880; i += gs) par[PQ_RPB + i] = a.in[I_RPB][i];
    }
    {
        f32x2* rope = (f32x2*)(ws + OFF_ROPE);
        for (int idx = obid() * 512 + tid; idx < SEQ * 32; idx += G * 512) {
            const int t = idx >> 5, i = idx & 31; const float pos = (float)((i < 16) ? (t >> 6) : (t & 63));
            const float inv = powf(10000.0f, -(float)(i & 15) / 16.0f); const float ang = pos * inv;
            rope[idx] = (f32x2){cosf(ang), sinf(ang)};
        }
    }
    __syncthreads();
    {
        LAS float* sl = (LAS float*)lds;
        LAS float* red = (LAS float*)(lds + 20480);
        for (int i = tid; i < 5 * 1024; i += 512) { const int r = i >> 10, k = i & 1023; const float v = (r < 4) ? a.in[I_C][r * 1024 + k] : a.in[I_CCTX][k]; sl[i] = v / (1.0f + __expf(-v)); }
        __syncthreads();
        float* mod = (float*)(ws + OFF_MOD);
        for (int item = obid(); item < 4 * 144; item += G) {
            const int l = item / 144, g = item % 144, col = tid & 63, ks = tid >> 6;
            const float* w = a.in[I_ADAW] + ((size_t)l * 1024 + ks * 128) * 9216 + g * 64 + col;
            const LAS float* s = sl + ks * 128;
            float a0 = 0, a1 = 0, a2 = 0, a3 = 0, a4 = 0;
            for (int k0 = 0; k0 < 128; k0 += 32) { float wv[32];
#pragma unroll
                for (int k = 0; k < 32; ++k) wv[k] = w[(size_t)(k0 + k) * 9216];
#pragma unroll
                for (int k = 0; k < 32; ++k) { a0 += s[k0 + k] * wv[k]; a1 += s[1024 + k0 + k] * wv[k]; a2 += s[2048 + k0 + k] * wv[k]; a3 += s[3072 + k0 + k] * wv[k]; a4 += s[4096 + k0 + k] * wv[k]; } }
            red[(ks * 5 + 0) * 64 + col] = a0; red[(ks * 5 + 1) * 64 + col] = a1; red[(ks * 5 + 2) * 64 + col] = a2; red[(ks * 5 + 3) * 64 + col] = a3; red[(ks * 5 + 4) * 64 + col] = a4;
            __syncthreads();
            if (tid < 320) { const int r = tid >> 6; float sum = a.in[I_ADAB][l * 9216 + g * 64 + col];
#pragma unroll
                for (int q = 0; q < 8; ++q) sum += red[(q * 5 + r) * 64 + col];
                mod[(size_t)(l * 5 + r) * 9216 + g * 64 + col] = sum; }
            __syncthreads();
        }
    }
}

__device__ __forceinline__ void phase_init_h(const KArgs& a) {
    unsigned char* wsq = optr(a.ws);
    const int lane = otid() & 63, gw = obid() * 8 + (otid() >> 6), NGW = gridDim.x * 8;
    const float* mod = (const float*)(wsq + OFF_MOD); bf16_t* Hb = (bf16_t*)(wsq + OFF_HB);
    f32x4 xv[4], nx[4];
#define IH_LOAD(XV, row_) do { const int r_ = (row_); const float* xs_ = (r_ < ML) ? a.in[I_X] + (size_t)r_ * DM : a.in[I_CTX] + (size_t)(r_ - ML) * DM; \
        _Pragma("unroll") for (int j = 0; j < 4; ++j) XV[j] = *(const f32x4*)(xs_ + 4 * lane + 256 * j); } while (0)
    if (gw < MR) IH_LOAD(xv, gw);
    for (int row = gw; row < MR; row += NGW) {
        if (row + NGW < MR) IH_LOAD(nx, row + NGW);
        const int rr = (row < ML) ? (row >> 13) : 4;
        const float* sh = mod + (size_t)rr * 9216; const float* sc = sh + 1024;
#pragma unroll
        for (int j = 0; j < 4; ++j) { const int c = 4 * lane + 256 * j; const f32x4 s1 = *(const f32x4*)(sc + c), s0 = *(const f32x4*)(sh + c);
            const f32x4 h = xv[j] * (1.0f + s1) + s0; u32x2 w; w.x = pk2(h[0], h[1]); w.y = pk2(h[2], h[3]); *(u32x2*)(Hb + (size_t)row * DM + c) = w; }
#pragma unroll
        for (int j = 0; j < 4; ++j) xv[j] = nx[j];
    }
#undef IH_LOAD
}

__device__ __forceinline__ void phase_ln(const float* xl_src, const float* xc_src, float* xl_dst, float* xc_dst, const bf16_t* Y, int ldy,
                                         const float* modg, float coef, const float* modh, bf16_t* Hb, const bf16_t* PART, int nparts) {
    const int lane = otid() & 63, gw = obid() * 8 + (otid() >> 6), NGW = gridDim.x * 8;
    f32x4 xv[4], nxv[4]; u32x2 yv[4], nyv[4]; f32x4 gq[4], s0q[4], s1q[4]; int cur_rr = -1;
#pragma unroll
    for (int j = 0; j < 4; ++j) { gq[j] = (f32x4){0.f, 0.f, 0.f, 0.f}; s0q[j] = gq[j]; s1q[j] = gq[j]; }
#define LN_LOAD(XV, YV, row_) do { const int r_ = (row_); const bool lat_ = r_ < ML; \
        const float* xs_ = lat_ ? xl_src + (size_t)r_ * DM : xc_src + (size_t)(r_ - ML) * DM; const bf16_t* y_ = Y + (size_t)r_ * ldy; \
        _Pragma("unroll") for (int j = 0; j < 4; ++j) { const int c = 4 * lane + 256 * j; XV[j] = *(const f32x4*)(xs_ + c); YV[j] = *(const u32x2*)(y_ + c); } } while (0)
    if (gw < MR) LN_LOAD(xv, yv, gw);
    for (int row = gw; row < MR; row += NGW) {
        const bool lat = row < ML; const int rr = lat ? (row >> 13) : 4;
        if (row + NGW < MR) LN_LOAD(nxv, nyv, row + NGW);
        float* xd = lat ? xl_dst + (size_t)row * DM : xc_dst + (size_t)(row - ML) * DM;
        if (rr != cur_rr) { cur_rr = rr;
#pragma unroll
            for (int j = 0; j < 4; ++j) { const int c = 4 * lane + 256 * j; gq[j] = *(const f32x4*)(modg + (size_t)rr * 9216 + c) * coef;
                if (modh) { s0q[j] = *(const f32x4*)(modh + (size_t)rr * 9216 + c); s1q[j] = *(const f32x4*)(modh + (size_t)rr * 9216 + 1024 + c) + 1.0f; } } }
        f32x4 t[4]; float s = 0.f;
#pragma unroll
        for (int j = 0; j < 4; ++j) { const int c = 4 * lane + 256 * j; const f32x4 gg = gq[j]; const u32x2 yw = yv[j];
            f32x4 yy;
            if (lat) { yy[0] = __uint_as_float(yw.x << 16); yy[1] = __uint_as_float(yw.x & 0xffff0000u); yy[2] = __uint_as_float(yw.y << 16); yy[3] = __uint_as_float(yw.y & 0xffff0000u); }
            else { yy = (f32x4){0.f, 0.f, 0.f, 0.f};
                u32x2 pw[11];
#pragma unroll
                for (int p = 0; p < 11; ++p) { pw[p] = (u32x2){0u, 0u}; if (p < nparts) pw[p] = *(const u32x2*)(PART + ((size_t)p * 1024 + (row - ML)) * 1024 + c); }
#pragma unroll
                for (int p = 0; p < 11; ++p) { yy[0] += __uint_as_float(pw[p].x << 16); yy[1] += __uint_as_float(pw[p].x & 0xffff0000u); yy[2] += __uint_as_float(pw[p].y << 16); yy[3] += __uint_as_float(pw[p].y & 0xffff0000u); } }
            t[j] = xv[j] * ALPHA + gg * yy; s += (t[j][0] + t[j][1]) + (t[j][2] + t[j][3]); }
        const float mean = wave_sum(s) * (1.0f / DM); float s2 = 0.f;
#pragma unroll
        for (int j = 0; j < 4; ++j) { t[j] = t[j] - mean; s2 += (t[j][0] * t[j][0] + t[j][1] * t[j][1]) + (t[j][2] * t[j][2] + t[j][3] * t[j][3]); }
        const float rstd = 1.0f / sqrtf(wave_sum(s2) * (1.0f / DM) + LN_EPS);
#pragma unroll
        for (int j = 0; j < 4; ++j) { const int c = 4 * lane + 256 * j; const f32x4 xn = t[j] * rstd; *(f32x4*)(xd + c) = xn;
            if (modh) { const f32x4 h = xn * s1q[j] + s0q[j];
                u32x2 w; w.x = pk2(h[0], h[1]); w.y = pk2(h[2], h[3]); *(u32x2*)(Hb + (size_t)row * DM + c) = w; } }
#pragma unroll
        for (int j = 0; j < 4; ++j) { xv[j] = nxv[j]; yv[j] = nyv[j]; }
    }
#undef LN_LOAD
}

__device__ __forceinline__ void phase_evenD(bf16_t* P, const float* qng, const float* kvng, const f32x2* rope) {
    const int lane = otid() & 63, gw = obid() * 8 + (otid() >> 6), NGW = gridDim.x * 8;
    const float g0 = qng[2 * lane], g1 = qng[2 * lane + 1], g2 = qng[2 * lane + 128], g3 = qng[2 * lane + 129], g4 = qng[2 * lane + 256], g5 = qng[2 * lane + 257];
    const float k0 = kvng[2 * lane], k1 = kvng[2 * lane + 1];
    unsigned w0, w1, w2, wk, wr; f32x2 cs; unsigned n0, n1, n2, nk, nr; f32x2 ncs;
#define ED_LOAD(W0, W1, W2, WK, WR, CS, row_) do { const bf16_t* p_ = P + (size_t)(row_) * PW; W0 = *(const unsigned*)(p_ + PC_CQ + 2 * lane); W1 = *(const unsigned*)(p_ + PC_CQ + 2 * lane + 128); \
        W2 = *(const unsigned*)(p_ + PC_CQ + 2 * lane + 256); WK = *(const unsigned*)(p_ + PC_CKV + 2 * lane); WR = *(const unsigned*)(p_ + PC_KR + 2 * (lane & 31)); \
        CS = rope[(size_t)((row_) & (SEQ - 1)) * 32 + (lane & 31)]; } while (0)
    if (gw < MR) ED_LOAD(w0, w1, w2, wk, wr, cs, gw);
    for (int row = gw; row < MR; row += NGW) {
        if (row + NGW < MR) ED_LOAD(n0, n1, n2, nk, nr, ncs, row + NGW);
        bf16_t* pr = P + (size_t)row * PW;
        { const float x0 = __uint_as_float(w0 << 16), x1 = __uint_as_float(w0 & 0xffff0000u), x2 = __uint_as_float(w1 << 16), x3 = __uint_as_float(w1 & 0xffff0000u), x4 = __uint_as_float(w2 << 16), x5 = __uint_as_float(w2 & 0xffff0000u);
          const float y0 = __uint_as_float(wk << 16), y1 = __uint_as_float(wk & 0xffff0000u);
          float ss = (x0 * x0 + x1 * x1) + (x2 * x2 + x3 * x3) + (x4 * x4 + x5 * x5), sk = y0 * y0 + y1 * y1;
#pragma unroll
          for (int o = 1; o < 64; o <<= 1) { ss += __shfl_xor(ss, o); sk += __shfl_xor(sk, o); }
          const float rs = __builtin_amdgcn_rsqf(ss * (1.0f / 384.0f) + LN_EPS), rk = __builtin_amdgcn_rsqf(sk * (1.0f / 128.0f) + LN_EPS);
          *(unsigned*)(pr + PC_CQ + 2 * lane) = pk2(x0 * rs * g0, x1 * rs * g1); *(unsigned*)(pr + PC_CQ + 2 * lane + 128) = pk2(x2 * rs * g2, x3 * rs * g3); *(unsigned*)(pr + PC_CQ + 2 * lane + 256) = pk2(x4 * rs * g4, x5 * rs * g5);
          *(unsigned*)(pr + PC_CKV + 2 * lane) = pk2(y0 * rk * k0, y1 * rk * k1); }
        if (row < ML && lane < 32) { const float x0 = __uint_as_float(wr << 16), x1 = __uint_as_float(wr & 0xffff0000u);
          *(unsigned*)(pr + PC_KR + 2 * lane) = pk2(x0 * cs.x - x1 * cs.y, x0 * cs.y + x1 * cs.x); }
        w0 = n0; w1 = n1; w2 = n2; wk = nk; wr = nr; cs = ncs;
    }
#undef ED_LOAD
}

__device__ __forceinline__ f32x16 mma_nt(const bf16_t* X, int ldx, const bf16_t* Y, int ldy, int nk, f32x16 acc, int r32, int hi) {
    for (int kk = 0; kk < nk; ++kk) { const bf16x8 a = *(const bf16x8*)(X + r32 * ldx + kk * 16 + hi * 8); const bf16x8 b = *(const bf16x8*)(Y + r32 * ldy + kk * 16 + hi * 8);
        acc = __builtin_amdgcn_mfma_f32_32x32x16_bf16(a, b, acc, 0, 0, 0); }
    return acc;
}
__device__ __forceinline__ int chunk_row0(int b, int cid) { return cid < 4 ? ML + b * CTXL + cid * 64 : b * SEQ + (cid - 4) * 64; }

#define LBAR() do { asm volatile("s_waitcnt lgkmcnt(0)" ::: "memory"); __builtin_amdgcn_s_barrier(); asm volatile("" ::: "memory"); } while (0)
__device__ __forceinline__ void gla_gates(const float* par, int ie, int h, int tid, const float* lrs, float* gs, float* qs) {
    const int dir = (tid >> 6) & 1, d = tid & 63, tq = tid >> 7;
    const float* wg = par + (dir ? PQ_WG2B : PQ_WG2F) + ie * 16 * 256 + h * 64 + d; const float bias = par[(dir ? PQ_BGB : PQ_BGF) + ie * 256 + h * 64 + d];
    float w[16];
#pragma unroll
    for (int j = 0; j < 16; ++j) w[j] = wg[j * 256];
    float run = 0.f;
#pragma unroll 4
    for (int tt = 0; tt < 16; ++tt) { const int t = tq * 16 + (dir ? 15 - tt : tt); float x = bias;
        const f32x4* lr4 = (const f32x4*)(lrs + t * 32 + dir * 16);
#pragma unroll
        for (int j4 = 0; j4 < 4; ++j4) { const f32x4 l = lr4[j4]; x += l[0] * w[4 * j4] + l[1] * w[4 * j4 + 1] + l[2] * w[4 * j4 + 2] + l[3] * w[4 * j4 + 3]; }
        run += logsig16(x); gs[(dir * 64 + t) * 64 + d] = run; }
    qs[(dir * 64 + d) * 4 + tq] = run;
}
__device__ __forceinline__ float gla_offset(const float* qs, int dir, int d, int tq, float& tot) {
    const f32x4 q = *(const f32x4*)(qs + (dir * 64 + d) * 4); tot = (q[0] + q[1]) + (q[2] + q[3]);
    float off = 0.f;
    if (dir == 0) { if (tq > 0) off += q[0]; if (tq > 1) off += q[1]; if (tq > 2) off += q[2]; }
    else { if (tq < 3) off += q[3]; if (tq < 2) off += q[2]; if (tq < 1) off += q[1]; }
    return off;
}
#define GLA_DECODE(uu, h_, cid_, b_, row0_) const int h_ = (uu) & 3, cid_ = ((uu) >> 2) % NCH, b_ = (uu) / (4 * NCH); const int row0_ = chunk_row0(b_, cid_)
__device__ __forceinline__ void phase_gla_c1(const KArgs& a, int ie, char* lds) {
    unsigned char* wsq = optr(a.ws);
    const float* par = (const float*)(wsq + OFF_PAR);
    const int tid = otid(), wid = tid >> 6, lane = tid & 63, r32 = lane & 31, hi = lane >> 5;
    const bf16_t* P = (const bf16_t*)(wsq + OFF_R); bf16_t* SL = (bf16_t*)(wsq + OFF_R + R_SL); float* DEC = (float*)(wsq + OFF_R + R_DEC);
    float* lrs = (float*)lds; float* gs = (float*)(lds + 8192); bf16_t* kdT = (bf16_t*)(lds + 40960); bf16_t* vT = (bf16_t*)(lds + 59392); bf16_t* Ks = (bf16_t*)(lds + 77824); float* qs = (float*)(lds + 86016);
    const int NU = NB * NCH * 4, G = gridDim.x;
    bf16x8 pk, pv0, pv1, plv;
#define C1_LOAD(uu) do { GLA_DECODE(uu, h_, cid_, b_, row0_); (void)cid_; (void)b_; \
        pk = *(const bf16x8*)(P + (size_t)(row0_ + (tid >> 3)) * PW + PC_K + h_ * 64 + (tid & 7) * 8); \
        pv0 = *(const bf16x8*)(P + (size_t)(row0_ + (tid & 63)) * PW + PC_V + h_ * 128 + (tid >> 6) * 8); \
        pv1 = *(const bf16x8*)(P + (size_t)(row0_ + (tid & 63)) * PW + PC_V + h_ * 128 + 64 + (tid >> 6) * 8); \
        plv = *(const bf16x8*)(P + (size_t)(row0_ + ((tid & 255) >> 2)) * PW + PC_LRF + (tid & 3) * 8); } while (0)
    int u = obid();
    if (u < NU) C1_LOAD(u);
    for (; u < NU; u += G) {
        GLA_DECODE(u, h, cid, b, row0); (void)row0;
        LBAR();
        *(bf16x8*)(Ks + tid * 8) = pk;
#pragma unroll
        for (int q = 0; q < 8; ++q) { vT[((tid >> 6) * 8 + q) * 72 + (tid & 63)] = (bf16_t)pv0[q]; vT[(64 + (tid >> 6) * 8 + q) * 72 + (tid & 63)] = (bf16_t)pv1[q]; }
        if (tid < 256) {
#pragma unroll
            for (int q = 0; q < 8; ++q) lrs[tid * 8 + q] = bf2f((unsigned short)plv[q]); }
        if (u + G < NU) C1_LOAD(u + G);
        LBAR();
        gla_gates(par, ie, h, tid, lrs, gs, qs);
        LBAR();
        { const int dir = (tid >> 6) & 1, d = tid & 63, tq = tid >> 7; float tot; const float off = gla_offset(qs, dir, d, tq, tot);
#pragma unroll 4
          for (int tt = 0; tt < 16; ++tt) { const int t = tq * 16 + tt; const float run = gs[(dir * 64 + t) * 64 + d] + off;
              kdT[(dir * 64 + d) * 72 + t] = f2bf(bf2f(Ks[t * 64 + d]) * __expf(tot - run)); }
          if (tq == 0) DEC[((size_t)((b * 2 + dir) * 4 + h) * NCH + cid) * 64 + d] = __expf(tot); }
        LBAR();
#pragma unroll
        for (int q = 0; q < 2; ++q) { const int ti = wid + 8 * q, dir = ti >> 3, ct = (ti >> 1) & 3, dt = ti & 1;
            f32x16 acc = f32x16{}; acc = mma_nt(vT + ct * 32 * 72, 72, kdT + (dir * 64 + dt * 32) * 72, 72, 4, acc, r32, hi);
            bf16_t* dst = SL + ((size_t)((b * 2 + dir) * 4 + h) * NCH + cid) * 8192;
#pragma unroll
            for (int r = 0; r < 16; ++r) dst[(ct * 32 + crow(r, hi)) * 64 + dt * 32 + r32] = f2bf(acc[r]); }
    }
    LBAR();
#undef C1_LOAD
}
__device__ __forceinline__ void phase_gla_c2(const KArgs& a) {
    unsigned char* wsq = optr(a.ws);
    bf16_t* SL = (bf16_t*)(wsq + OFF_R + R_SL); const float* DEC = (const float*)(wsq + OFF_R + R_DEC);
    for (int gid = obid() * 512 + otid(); gid < 32 * 4096; gid += gridDim.x * 512) {
        const int bdh = gid >> 12, e = (gid & 4095) * 2, d = e & 63, dir = (bdh >> 2) & 1;
        float S0 = 0.f, S1 = 0.f;
        unsigned loc[12], nloc[12]; f32x2 dd[12], ndd[12];
#define C2_LOAD(L, D, s0_) do { _Pragma("unroll") for (int q = 0; q < 12; ++q) { const int s = (s0_) + q; const int cid = dir ? (s < 4 ? 3 - s : 135 - s) : s; const size_t idx = (size_t)bdh * NCH + cid; \
            L[q] = *(const unsigned*)(SL + idx * 8192 + e); D[q] = *(const f32x2*)(DEC + idx * 64 + d); } } while (0)
        C2_LOAD(loc, dd, 0);
        for (int s0 = 0; s0 < NCH; s0 += 12) {
            if (s0 + 12 < NCH) C2_LOAD(nloc, ndd, s0 + 12);
#pragma unroll
            for (int q = 0; q < 12; ++q) { const int s = s0 + q; const int cid = dir ? (s < 4 ? 3 - s : 135 - s) : s; const size_t idx = (size_t)bdh * NCH + cid;
                *(unsigned*)(SL + idx * 8192 + e) = pk2(S0, S1); S0 = S0 * dd[q].x + __uint_as_float(loc[q] << 16); S1 = S1 * dd[q].y + __uint_as_float(loc[q] & 0xffff0000u); }
#pragma unroll
            for (int q = 0; q < 12; ++q) { loc[q] = nloc[q]; dd[q] = ndd[q]; }
        }
#undef C2_LOAD
    }
}
__device__ __forceinline__ void phase_gla_c3(const KArgs& a, int ie, char* lds) {
    unsigned char* wsq = optr(a.ws);
    const float* par = (const float*)(wsq + OFF_PAR);
    const int tid = otid(), wid = tid >> 6, lane = tid & 63, r32 = lane & 31, hi = lane >> 5;
    const bf16_t* P = (const bf16_t*)(wsq + OFF_R); const bf16_t* SL = (const bf16_t*)(wsq + OFF_R + R_SL); bf16_t* CAT = (bf16_t*)(wsq + OFF_HB);
    float* lrs = (float*)lds; bf16_t* QE = (bf16_t*)(lds + 8192); bf16_t* KE = (bf16_t*)(lds + 25600); bf16_t* VT = (bf16_t*)(lds + 44032);
    bf16_t* ST = (bf16_t*)(lds + 62464); float* gs = (float*)(lds + 62464);
    bf16_t* AM = (bf16_t*)(lds + 97280); float* part = (float*)(lds + 106496); bf16_t* Ks = (bf16_t*)(lds + 107520); bf16_t* Qs = (bf16_t*)(lds + 115712); float* qs = (float*)(lds + 123904);
    const float* ng = par + PQ_GLANG + ie * 128;
    const int NU = NB * NCH * 4, G = gridDim.x;
    const int oit = wid >> 2, oct = wid & 3;
    bf16x8 pk, pq, pv0, pv1, plv, psv[4]; bf16_t prg[16];
#define C3_LOAD_A(uu) do { GLA_DECODE(uu, h_, cid_, b_, row0_); (void)cid_; (void)b_; \
        pk = *(const bf16x8*)(P + (size_t)(row0_ + (tid >> 3)) * PW + PC_K + h_ * 64 + (tid & 7) * 8); \
        pq = *(const bf16x8*)(P + (size_t)(row0_ + (tid >> 3)) * PW + PC_Q + h_ * 64 + (tid & 7) * 8); \
        pv0 = *(const bf16x8*)(P + (size_t)(row0_ + (tid & 63)) * PW + PC_V + h_ * 128 + (tid >> 6) * 8); \
        pv1 = *(const bf16x8*)(P + (size_t)(row0_ + (tid & 63)) * PW + PC_V + h_ * 128 + 64 + (tid >> 6) * 8); \
        plv = *(const bf16x8*)(P + (size_t)(row0_ + ((tid & 255) >> 2)) * PW + PC_LRF + (tid & 3) * 8); } while (0)
#define C3_LOAD_B(uu) do { GLA_DECODE(uu, h_, cid_, b_, row0_); \
        _Pragma("unroll") for (int q = 0; q < 4; ++q) { const int i = tid + 512 * q, dir = i >> 10, c = (i >> 3) & 127, d8 = (i & 7) * 8; \
            psv[q] = *(const bf16x8*)(SL + ((size_t)((b_ * 2 + dir) * 4 + h_) * NCH + cid_) * 8192 + c * 64 + d8); } \
        _Pragma("unroll") for (int r = 0; r < 16; ++r) prg[r] = P[(size_t)(row0_ + oit * 32 + crow(r, hi)) * PW + PC_R + h_ * 128 + oct * 32 + r32]; } while (0)
    int u = obid();
    if (u < NU) { C3_LOAD_A(u); C3_LOAD_B(u); }
    for (; u < NU; u += G) {
        GLA_DECODE(u, h, cid, b, row0); (void)cid; (void)b;
        bf16_t crg[16];
#pragma unroll
        for (int r = 0; r < 16; ++r) crg[r] = prg[r];
        LBAR();
        *(bf16x8*)(Ks + tid * 8) = pk; *(bf16x8*)(Qs + tid * 8) = pq;
#pragma unroll
        for (int q = 0; q < 8; ++q) { VT[((tid >> 6) * 8 + q) * 72 + (tid & 63)] = (bf16_t)pv0[q]; VT[(64 + (tid >> 6) * 8 + q) * 72 + (tid & 63)] = (bf16_t)pv1[q]; }
        if (tid < 256) {
#pragma unroll
            for (int q = 0; q < 8; ++q) lrs[tid * 8 + q] = bf2f((unsigned short)plv[q]); }
        if (u + G < NU) C3_LOAD_A(u + G);
        LBAR();
        gla_gates(par, ie, h, tid, lrs, gs, qs);
        LBAR();
        { const int dir = (tid >> 6) & 1, d = tid & 63, tq = tid >> 7; float tot; const float off = gla_offset(qs, dir, d, tq, tot); (void)tot;
#pragma unroll 4
          for (int tt = 0; tt < 16; ++tt) { const int t = tq * 16 + tt; const float run = gs[(dir * 64 + t) * 64 + d] + off;
              const float q = bf2f(Qs[t * 64 + d]) * 0.125f, k = bf2f(Ks[t * 64 + d]);
              QE[t * 136 + dir * 64 + d] = f2bf(q * __expf(run)); KE[(dir * 64 + t) * 72 + d] = f2bf(k * __expf(-run)); } }
        LBAR();
#pragma unroll
        for (int q = 0; q < 4; ++q) { const int i = tid + 512 * q, dir = i >> 10, c = (i >> 3) & 127, d8 = (i & 7) * 8; *(bf16x8*)(ST + c * 136 + dir * 64 + d8) = psv[q]; }
        { const int tile = wid & 3, dir = wid >> 2, it = tile >> 1, jt = tile & 1;
          f32x16 acc = f32x16{}; acc = mma_nt(QE + it * 32 * 136 + dir * 64, 136, KE + (dir * 64 + jt * 32) * 72, 72, 4, acc, r32, hi);
#pragma unroll
          for (int r = 0; r < 16; ++r) { const int i = it * 32 + crow(r, hi), j = jt * 32 + r32; const bool own = dir ? (i < j) : (i >= j); if (own) AM[i * 72 + j] = f2bf(acc[r]); } }
        if (u + G < NU) C3_LOAD_B(u + G);
        LBAR();
        { const int it = oit, ct = oct;
          f32x16 acc = f32x16{}; acc = mma_nt(AM + it * 32 * 72, 72, VT + ct * 32 * 72, 72, 4, acc, r32, hi);
          acc = mma_nt(QE + it * 32 * 136, 136, ST + ct * 32 * 136, 136, 8, acc, r32, hi);
          float ss[16];
#pragma unroll
          for (int r = 0; r < 16; ++r) { float v = acc[r] * acc[r]; v += __shfl_xor(v, 1); v += __shfl_xor(v, 2); v += __shfl_xor(v, 4); v += __shfl_xor(v, 8); v += __shfl_xor(v, 16); ss[r] = v; }
          if (r32 == 0) {
#pragma unroll
              for (int r = 0; r < 16; ++r) part[ct * 64 + it * 32 + crow(r, hi)] = ss[r]; }
          const int c = ct * 32 + r32; const float gn = ng[c];
          LBAR();
#pragma unroll
          for (int r = 0; r < 16; ++r) { const int i = it * 32 + crow(r, hi); const float tot = part[i] + part[64 + i] + part[128 + i] + part[192 + i];
              const float rs = __builtin_amdgcn_rsqf(tot * (1.0f / 128.0f) + LN_EPS); const float rg = bf2f(crg[r]);
              CAT[(size_t)(row0 + i) * DM + h * 128 + c] = f2bf(acc[r] * rs * gn * (rg * __builtin_amdgcn_rcpf(1.0f + __expf(-rg)))); } }
    }
    LBAR();
#undef C3_LOAD_A
#undef C3_LOAD_B
}

__device__ __forceinline__ void phase_mla(const KArgs& a, char* lds) {
    unsigned char* wsq = optr(a.ws);
    const bf16_t* P = (const bf16_t*)(wsq + OFF_R); const bf16_t* QB = (const bf16_t*)(wsq + OFF_R + R_QB); const bf16_t* KVB = (const bf16_t*)(wsq + OFF_R + R_KVB);
    bf16_t* CAT = (bf16_t*)(wsq + OFF_HB);
    const float scale = 0.07216878364870322f;
    const int G_ = (int)gridDim.x, bi_ = obid(), nlat_ = (512 - bi_ + G_ - 1) / G_;
    for (int i = 0;; ++i) {
        int id;
        if (i < nlat_) id = i * G_ + bi_;
        else if (i == nlat_ && G_ >= 16 && bi_ >= G_ - 16) id = 512 + (bi_ - (G_ - 16));
        else if (G_ < 16 && 512 + (i - nlat_) * G_ + bi_ < 528) id = 512 + (i - nlat_) * G_ + bi_;
        else break;
        fa::Args A; int b, h;
        if (id < 512) { const int c = id & 255, rnd = id >> 8; const int bh = (c & 7) + 8 * rnd, qb = c >> 3; b = bh >> 2; h = bh & 3;
            const int qrow = b * SEQ + qb * 256; A.Q = QB + (size_t)qrow * 768 + h * 192; A.O = CAT + (size_t)qrow * DM + 512 + h * 128; A.NT = NCH; A.rope = (const f32x2*)(wsq + OFF_ROPE); A.pos0 = qb * 256; }
        else { const int c = id - 512; b = c >> 2; h = c & 3; const int qrow = ML + b * CTXL; A.Q = QB + (size_t)qrow * 768 + h * 192; A.O = CAT + (size_t)qrow * DM + 512 + h * 128; A.NT = 4; A.rope = nullptr; A.pos0 = 0; }
        A.ldq = 768; A.ldo = DM; A.K1 = KVB + h * 256; A.ldk1 = 1024; A.K2 = P + PC_KR; A.ldk2 = PW; A.V = KVB + h * 256 + 128; A.ldv = 1024;
        A.ctxrow0 = ML + b * CTXL; A.latrow0 = b * SEQ; A.C = scale * 1.4426950408889634f; A.thr = 8.0f / scale; A.rpb = nullptr; A.masked = 0; A.r0 = 0; A.krow0 = 0;
#ifndef NO_MLA
        fa::flash_unit<192, 128, false>(lds, A);
#endif
    }
}
__device__ __forceinline__ void phase_na(const KArgs& a, int io, char* lds) {
    unsigned char* wsq = optr(a.ws);
    const bf16_t* QKV = (const bf16_t*)(wsq + OFF_R); bf16_t* CAT = (bf16_t*)(wsq + OFF_HB);
    for (int i = 0;; ++i) {
        const int id = i * gridDim.x + obid(); if (id >= 2048 + 64) break;
        fa::Args A; int b, h;
        if (id < 2048) { const int rb = id & 31; h = (id >> 5) & 15; b = id >> 9; const int qrow = b * SEQ + rb * 256; const int r0 = rb * 4, krow0 = min(max(r0 - 4, 0), 116);
            A.Q = QKV + (size_t)qrow * 3072 + h * 64; A.O = CAT + (size_t)qrow * DM + h * 64; A.NT = 16; A.masked = 1; A.r0 = r0; A.krow0 = krow0; A.latrow0 = b * SEQ + krow0 * 64;
            A.rpb = (const float*)(wsq + OFF_PAR) + PQ_RPB + (size_t)(io * 16 + h) * 465; }
        else { const int c = id - 2048; b = c >> 4; h = c & 15; const int qrow = ML + b * CTXL;
            A.Q = QKV + (size_t)qrow * 3072 + h * 64; A.O = CAT + (size_t)qrow * DM + h * 64; A.NT = 4; A.masked = 0; A.r0 = 0; A.krow0 = 0; A.latrow0 = 0; A.rpb = nullptr; }
        A.ldq = 3072; A.ldo = DM; A.K1 = QKV + 1024 + h * 64; A.ldk1 = 3072; A.K2 = nullptr; A.ldk2 = 0; A.V = QKV + 2048 + h * 64; A.ldv = 3072;
        A.ctxrow0 = ML + b * CTXL; A.C = 0.125f * 1.4426950408889634f; A.thr = 64.0f; A.rope = nullptr; A.pos0 = 0;
#ifndef NO_NA
        fa::flash_unit<64, 64, true>(lds, A);
#endif
    }
}

#define XB_TMO      128
#define XB_XCNT(j)  (256  + 64 * (j))
#define XB_XSUB(j)  (1280 + 64 * (j))
#define XB_XGEN(j)  (2304 + 64 * (j))
#define XB_TOP      3328
#define XB_TOPGEN   3392
#define XCD_BAR_WORDS 3456
#define XB_SPIN_CAP (1u << 18)
__device__ __forceinline__ unsigned xb_ld(unsigned* p)              { return __hip_atomic_load(p, __ATOMIC_RELAXED, __HIP_MEMORY_SCOPE_AGENT); }
__device__ __forceinline__ unsigned xb_add(unsigned* p, unsigned v) { return __hip_atomic_fetch_add(p, v, __ATOMIC_RELAXED, __HIP_MEMORY_SCOPE_AGENT); }
__device__ __forceinline__ unsigned xb_xcc_id() { return (unsigned)__builtin_amdgcn_s_getreg((3 << 11) | 20) & 0xFu; }
#define XB_SPIN(cond, bar) do { unsigned _sp = 0; while (cond) { __builtin_amdgcn_s_sleep(1); \
    if ((++_sp & 255u) == 0u) { if (xb_ld(&(bar)[XB_TMO])) break; if (_sp > XB_SPIN_CAP) { atomicAdd(&(bar)[XB_TMO], 1u); break; } } } } while (0)
__device__ __forceinline__ void xcd_barrier_complete(unsigned* bar, unsigned x, unsigned& nloc, unsigned& nx) {
    const unsigned G = gridDim.x * gridDim.y * gridDim.z;
    unsigned sum, cnt, mine, sp = 0u;
    for (;;) {
        sum = 0u; cnt = 0u; mine = 0u;
#pragma unroll
        for (unsigned j = 0; j < 16; ++j) { const unsigned c = xb_ld(&bar[XB_XCNT(j)]); sum += c; cnt += (c > 0u) ? 1u : 0u; mine = (j == x) ? c : mine; }
        if (sum == G) break;
        __builtin_amdgcn_s_sleep(1);
        if ((++sp & 255u) == 0u) { if (xb_ld(&bar[XB_TMO])) break; if (sp > XB_SPIN_CAP) { atomicAdd(&bar[XB_TMO], 1u); break; } }
    }
    nloc = mine > 0u ? mine : 1u; nx = cnt > 0u ? cnt : 1u;
}
__device__ __forceinline__ void xcd_barrier(unsigned* bar, volatile LAS unsigned* st) {
    asm volatile("s_waitcnt vmcnt(0)" ::: "memory");
    __syncthreads();
    if (threadIdx.x == 0) {
        __builtin_amdgcn_s_waitcnt(0);
        const unsigned x = xb_xcc_id();
        unsigned nloc = st[0], nx = st[1];
        if (nloc == 0u) { xcd_barrier_complete(bar, x, nloc, nx); st[0] = nloc; st[1] = nx; }
        const unsigned old = xb_add(&bar[XB_XSUB(x)], 1u);
        const unsigned gen = old / nloc;
        if (old + 1u == (gen + 1u) * nloc) {
            __builtin_amdgcn_fence(__ATOMIC_RELEASE, "agent");
            asm volatile("s_waitcnt vmcnt(0)" ::: "memory");
            const unsigned og = xb_add(&bar[XB_TOP], 1u);
            const unsigned tg = og / nx;
            if (og + 1u == (tg + 1u) * nx) xb_add(&bar[XB_TOPGEN], 1u);
            else XB_SPIN(xb_ld(&bar[XB_TOPGEN]) == tg, bar);
            __builtin_amdgcn_fence(__ATOMIC_ACQUIRE, "agent");
            xb_add(&bar[XB_XGEN(x)], 1u);
            asm volatile("s_waitcnt vmcnt(0)" ::: "memory");
        } else {
            XB_SPIN(xb_ld(&bar[XB_XGEN(x)]) == gen, bar);
            __builtin_amdgcn_fence(__ATOMIC_ACQUIRE, "agent");
            asm volatile("s_waitcnt vmcnt(0)" ::: "memory");
        }
    }
    __syncthreads();
}

constexpr int LDS_BYTES = 147456;
constexpr int NPH = 2 + 4 * 12;

__global__ void __launch_bounds__(512, 2) mega(KArgs a) {
    extern __shared__ __attribute__((aligned(16))) unsigned char lds[];
    cg::grid_group grid = cg::this_grid();
    volatile LAS unsigned* bst = (volatile LAS unsigned*)((LAS unsigned char*)lds + 131072 + 64);
    unsigned* bar = (unsigned*)(a.ws + OFF_BAR);
    if (threadIdx.x == 0) { bst[0] = 0u; bst[1] = 0u; (void)xb_add(&bar[XB_XCNT(xb_xcc_id())], 1u); }
    __syncthreads();
    bool first = true;
    if (a.lo == 0) {
        for (int rep = 0; rep < 1 + ((DUP >> 5) & 1); ++rep) { phase_prep(a, lds); __syncthreads(); }
        if (a.hi < 0) grid.sync();
        xcd_barrier((unsigned*)(optr(a.ws) + OFF_BAR), bst);
        phase_init_h(a);
        first = false;
    }
    for (int ph = (a.lo < 2 ? 2 : a.lo); ph < a.hi; ++ph) {
        int l = 0, st = -1;
        if (ph >= 2) { l = (ph - 2) / 12; st = (ph - 2) % 12; }
        const bool odd = (l & 1) != 0; const int ie = l >> 1;
        if (ph >= 2 && odd && (st == 5 || st == 6)) continue;
        if (!first) { xcd_barrier((unsigned*)(optr(a.ws) + OFF_BAR), bst); if ((DUP >> 6) & 1) xcd_barrier((unsigned*)(optr(a.ws) + OFF_BAR), bst); }
        first = false;
        unsigned char* ws = optr(a.ws);
        float* mod = (float*)(ws + OFF_MOD); bf16_t* Hb = (bf16_t*)(ws + OFF_HB); float* Xc = (float*)(ws + OFF_XC);
        unsigned char* wl = ws + OFF_W + (size_t)l * WL_BYTES; unsigned char* we = ws + OFF_WE + (size_t)ie * 8 * MiB; unsigned char* wo = ws + OFF_WO + (size_t)ie * 8 * MiB;
        const float* modl = mod + (size_t)l * 5 * 9216;
        if (st == 0 || st == 9) {
            pg8::Gemm g{Hb, (const bf16_t*)(wl + (st == 0 ? 0 : W2IN_O)), MR, 2 * DFF, DM, DM, DM};
            pg8::StaticOrder S; S.init((l == 3 && st == 9) ? ML : MR, 2 * DFF, DM, gridDim.x, obid(), 0);
            pg8::EpiSwiglu E{(bf16_t*)(ws + OFF_R), DFF};
            for (int rep = 0; rep < 1 + ((DUP >> 3) & 1); ++rep) pg8::gemm_phase<pg8::EpiSwiglu>((LAS unsigned char*)lds, g, S, E);
            if (st == 0 && l < 3) {
                const int bi = obid(), nfree = (int)gridDim.x - 88;
                if (nfree > 0 && bi >= 88) { const int otw = otid(); convert_layer(a, l + 1, (bi - 88) * 8 + (otw >> 6), nfree * 8, (LAS float*)((LAS unsigned char*)lds + (otw >> 6) * 16384), otw & 63); }
                else if (nfree <= 0) { const int otw = otid(); convert_layer(a, l + 1, bi * 8 + (otw >> 6), (int)gridDim.x * 8, (LAS float*)((LAS unsigned char*)lds + (otw >> 6) * 16384), otw & 63); }
            }
        }
        else if (st == 1 || st == 3 || st == 5 || st == 7 || st == 10) {
            const int nsub = (st == 5) ? 2 : 1;
            for (int sub = 0; sub < nsub; ++sub) {
                pg8::Gemm g; pg8::EpiStore E; bf16_t* PARTB = (bf16_t*)(ws + OFF_R + R_PART);
                if (st == 1 || st == 10) { g = pg8::Gemm{(const bf16_t*)(ws + OFF_R), (const bf16_t*)(wl + (st == 1 ? W1OUT_O : W2OUT_O)), MR, DM, DFF, DFF, DFF}; E = pg8::EpiStore{Hb, DM, DM, PARTB}; }
                else if (st == 3) {
                    if (!odd) { g = pg8::Gemm{Hb, (const bf16_t*)we, MR, 2304, DM, DM, DM}; E = pg8::EpiStore{(bf16_t*)(ws + OFF_R), PW, PW, nullptr}; }
                    else { g = pg8::Gemm{Hb, (const bf16_t*)wo, MR, 3072, DM, DM, DM}; E = pg8::EpiStore{(bf16_t*)(ws + OFF_R), 3072, 3072, nullptr}; }
                }
                else if (st == 5) {
                    if (sub == 0) { g = pg8::Gemm{(const bf16_t*)(ws + OFF_R) + PC_CQ, (const bf16_t*)(we + WUQ_O), MR, 768, 384, PW, 384}; E = pg8::EpiStore{(bf16_t*)(ws + OFF_R + R_QB), 768, 768, nullptr}; }
                    else { g = pg8::Gemm{(const bf16_t*)(ws + OFF_R) + PC_CKV, (const bf16_t*)(we + WUKV_O), MR, 1024, 128, PW, 128}; E = pg8::EpiStore{(bf16_t*)(ws + OFF_R + R_KVB), 1024, 1024, nullptr}; }
                }
                else { g = pg8::Gemm{Hb, (const bf16_t*)(odd ? wo + WNO_O : we + WEO_O), MR, DM, DM, DM, DM}; E = pg8::EpiStore{(bf16_t*)(ws + OFF_R + (odd ? R_YODD : 0)), DM, DM, PARTB}; }
                pg8::StaticOrder S; S.init(g.M, g.N, g.K, gridDim.x, obid(), (st == 1 || st == 10 || st == 7) ? 1 : 0); if (l == 3 && st == 10) S.nextra = 0;
                for (int rep = 0; rep < 1 + (((DUP >> 4) & 1) & (st == 1 || st == 10)); ++rep) pg8::gemm_phase<pg8::EpiStore>((LAS unsigned char*)lds, g, S, E);
            }
#ifndef NO_C2
            if (st == 5) phase_gla_c2(a);
#endif
        }
        else if (st == 2 || st == 8 || st == 11) {
            const float* xl_src = (l == 0 && st == 2) ? a.in[I_X] : a.out; const float* xc_src = (l == 0 && st == 2) ? a.in[I_CTX] : Xc;
            const bf16_t* Y = (st == 8) ? (const bf16_t*)(ws + OFF_R + (odd ? R_YODD : 0)) : Hb;
            const float* modg = modl + (st == 2 ? 2 : st == 8 ? 5 : 8) * 1024; const float coef = (st == 8) ? 1.0f : 0.5f;
            const float* modh = (st == 2) ? modl + 3 * 1024 : (st == 8) ? modl + 6 * 1024 : (l < 3 ? modl + 5 * 9216 : nullptr);
            if (((DUP >> 7) & 1) && st != 8) phase_ln(xl_src, xc_src, (float*)(ws + OFF_R), (float*)(ws + OFF_R + 128 * MiB), Y, DM, modg, coef, modh, (bf16_t*)(ws + OFF_R + 140 * MiB), (const bf16_t*)(ws + OFF_R + R_PART), (st == 8) ? 4 : 11);
            phase_ln(xl_src, xc_src, a.out, Xc, Y, DM, modg, coef, modh, Hb, (const bf16_t*)(ws + OFF_R + R_PART), (st == 8) ? 4 : 11);
        }
        else if (st == 4) {
            if (!odd) { phase_evenD((bf16_t*)(ws + OFF_R), (const float*)(ws + OFF_PAR) + PQ_QNG + ie * 384, (const float*)(ws + OFF_PAR) + PQ_KVNG + ie * 128, (const f32x2*)(ws + OFF_ROPE));
 for (int rep = 0; rep < 1 + ((DUP >> 2) & 1); ++rep) phase_gla_c1(a, ie, (char*)lds);
 }
            else for (int rep = 0; rep < 1 + ((DUP >> 1) & 1); ++rep) phase_na(a, ie, (char*)lds);
        }
        else if (st == 6) { for (int rep = 0; rep < 1 + ((DUP >> 0) & 1); ++rep) phase_mla(a, (char*)lds);
 for (int rep = 0; rep < 1 + ((DUP >> 2) & 1); ++rep) phase_gla_c3(a, ie, (char*)lds);
 }
    }
}

extern "C" void kernel_launch(void* const* d_in, const int* in_sizes, int n_in, void* d_out, int out_size, void* d_ws, size_t ws_size, hipStream_t stream) {
    static int grid = 0;
    if (grid == 0) {
        if (n_in != 24 || in_sizes[0] != ML * DM || out_size != ML * DM || ws_size < WS_END) {
            fprintf(stderr, "kernel_launch: unexpected shapes (n_in %d, in0 %d, out %d, ws %zu need %zu); nothing launched\n", n_in, n_in > 0 ? in_sizes[0] : -1, out_size, ws_size, (size_t)WS_END); grid = -1; return; }
        int dev = 0, cus = 0, per_cu = 0;
        hipGetDevice(&dev); hipDeviceGetAttribute(&cus, hipDeviceAttributeMultiprocessorCount, dev);
        if (hipFuncSetAttribute((const void*)mega, hipFuncAttributeMaxDynamicSharedMemorySize, LDS_BYTES) != hipSuccess) { fprintf(stderr, "kernel_launch: hipFuncSetAttribute failed\n"); grid = -1; return; }
        if (hipOccupancyMaxActiveBlocksPerMultiprocessor(&per_cu, (const void*)mega, 512, LDS_BYTES) != hipSuccess || per_cu < 1) { fprintf(stderr, "kernel_launch: occupancy query says %d blocks per CU\n", per_cu); per_cu = 1; }
        (void)hipGetLastError();
        grid = cus * per_cu;
    }
    if (grid < 0) return;
    KArgs a{};
    for (int i = 0; i < 24; ++i) a.in[i] = (const float*)d_in[i];
    a.out = (float*)d_out; a.ws = (unsigned char*)d_ws; a.lo = 0; a.hi = DBG_HI;
    (void)hipMemsetAsync((char*)d_ws + OFF_BAR, 0, 16384, stream);
    void* args[] = {&a};
    hipError_t e = hipLaunchCooperativeKernel((const void*)mega, dim3(grid), dim3(512), args, LDS_BYTES, stream);
    if (e != hipSuccess) fprintf(stderr, "kernel_launch: cooperative launch failed: %s (grid %d)\n", hipGetErrorString(e), grid);
}
```

```cpp
#include <hip/hip_runtime.h>
#include <hip/hip_cooperative_groups.h>
#include <cstdio>
#include <cstdint>
namespace cg = cooperative_groups;
#ifndef DBG_HI
#define DBG_HI NPH
#endif
#ifndef DUP
#define DUP 0
#endif

#define LAS __attribute__((address_space(3)))
typedef unsigned short bf16_t;
typedef short bf16x8 __attribute__((ext_vector_type(8)));
typedef short s16x4 __attribute__((ext_vector_type(4)));
typedef float f32x4 __attribute__((ext_vector_type(4)));
typedef float f32x2 __attribute__((ext_vector_type(2)));
typedef float f32x16 __attribute__((ext_vector_type(16)));
typedef unsigned u32x4 __attribute__((ext_vector_type(4)));
typedef unsigned u32x2 __attribute__((ext_vector_type(2)));

constexpr int DM = 1024, NB = 4, SEQ = 8192, CTXL = 256, ML = NB * SEQ, MC = NB * CTXL, MR = ML + MC;
constexpr int DFF = 2816, PW = 2144, NCH = 132;
constexpr float LN_EPS = 1e-6f;
constexpr float ALPHA = 1.6817928305074290f;
constexpr int PC_Q = 0, PC_K = 256, PC_V = 512, PC_R = 1024, PC_LRF = 1536, PC_CQ = 1568, PC_CKV = 1952, PC_KR = 2080;

constexpr size_t MiB = 1u << 20;
constexpr size_t OFF_MOD = 0;
constexpr size_t OFF_PAR = 768 * 1024;
constexpr int PQ_QNG = 0, PQ_KVNG = 768, PQ_WG2F = 1024, PQ_BGF = 9216, PQ_WG2B = 9728, PQ_BGB = 17920, PQ_GLANG = 18432, PQ_RPB = 18688;
constexpr size_t OFF_BAR = 960 * 1024;
constexpr size_t OFF_ROPE = 1 * MiB;
constexpr size_t OFF_XC = 3 * MiB;
constexpr size_t OFF_W = 7 * MiB;
constexpr size_t WL_BYTES = 33 * MiB, W1OUT_O = 11 * MiB, W2IN_O = 16 * MiB + MiB / 2, W2OUT_O = 27 * MiB + MiB / 2;
constexpr size_t OFF_WE = OFF_W + 4 * WL_BYTES;
constexpr size_t WUQ_O = 4 * MiB + MiB / 2, WUKV_O = 5 * MiB + MiB / 4, WEO_O = 5 * MiB + MiB / 2;
constexpr size_t OFF_WO = OFF_WE + 16 * MiB;
constexpr size_t WNO_O = 6 * MiB;
constexpr size_t OFF_HB = OFF_WO + 16 * MiB;
constexpr size_t OFF_R = OFF_HB + 66 * MiB;
constexpr size_t R_SL = 139 * MiB, R_DEC = 205 * MiB, R_QB = 207 * MiB, R_KVB = 257 * MiB, R_END = 323 * MiB;
constexpr size_t R_YODD = 198 * MiB;
constexpr size_t R_PART = 270 * MiB;
constexpr size_t WS_END = OFF_R + R_END;

__device__ __forceinline__ int otid() { int t = threadIdx.x; asm volatile("" : "+v"(t)); return t; }
__device__ __forceinline__ int obid() { int b = blockIdx.x; asm volatile("" : "+s"(b)); return b; }
__device__ __forceinline__ unsigned char* optr(unsigned char* p) { size_t z = 0; asm volatile("" : "+s"(z)); return p + z; }

namespace pg8 {
constexpr int BM = 256, BK = 64, HALF = 128, HTB = HALF * BK * 2, STAGE_BYTES = 8 * HTB, NXCD = 8, WGM = 8;
__host__ __device__ __forceinline__ int lds_byte(int r, int c) { const int st = (r >> 4) * 2 + (c >> 5), rr = r & 15, cc = c & 31, ob = rr * 64 + cc * 2; return st * 1024 + (ob ^ (((ob >> 9) & 1) << 5)); }
__host__ __device__ __forceinline__ void stage_rc(int b, int& R, int& C) { const int st = b / 1024, sb = b % 1024, swz = sb ^ (((sb >> 9) & 1) << 5); R = (st >> 1) * 16 + swz / 64; C = (st & 1) * 32 + (swz % 64) / 2; }
__host__ __device__ __forceinline__ int perm32(int rho) { const int n = rho >> 4, i = rho & 15; return 8 * (i >> 2) + 4 * n + (i & 3); }
struct Unit { int pm, pn, kt0, nt, part; };
struct Gemm { const bf16_t* A; const bf16_t* Bt; int M, N, K, lda, ldb; };
struct StaticOrder {
    int nM, nN, nwg, G, c, ntk, nsplit, nextra;
    __device__ void init(int M, int N, int K, int G_, int c_, int split) { nN = N / BM; ntk = K / BK; nM = split ? 128 : M / BM; nsplit = split ? ntk / 4 : 0; nextra = 4 * nN * nsplit; nwg = nM * nN; G = G_; c = c_; }
    __device__ bool next(int i, Unit& u) const {
        long L = (long)i * G + c;
        if (L >= nwg) { L -= nwg; if (L >= nextra) return false; const int part = (int)L % nsplit, tile = (int)L / nsplit; u.pn = tile % nN; u.pm = 128 + tile / nN; u.kt0 = part * 4; u.nt = 4; u.part = part; return true; }
        int wgid = (int)L; { const int q = nwg / NXCD, r = nwg % NXCD, xcd = wgid % NXCD, off = wgid / NXCD; wgid = (xcd < r ? xcd * (q + 1) : r * (q + 1) + (xcd - r) * q) + off; }
        const int nig = WGM * nN, gid = wgid / nig, fm = gid * WGM, gsz = (nM - fm) < WGM ? (nM - fm) : WGM;
        u.pm = fm + ((wgid % nig) % gsz); u.pn = (wgid % nig) / gsz; u.kt0 = 0; u.nt = ntk; u.part = -1; return true;
    }
};
typedef __bf16 bf16x2_t __attribute__((ext_vector_type(2)));
__device__ __forceinline__ unsigned cvt_pk_bf16(float lo, float hi) { f32x2 v = {lo, hi}; bf16x2_t b = __builtin_convertvector(v, bf16x2_t); return __builtin_bit_cast(unsigned, b); }

struct EpiStore {
    static constexpr bool PERM = true;
    bf16_t* O; int ldc; int ncols; bf16_t* PART;
    __device__ __forceinline__ void operator()(const f32x4 (&acc)[2][2][4][2], const Unit& u, int wr, int wc, int fr, int fq) const {
        int row0 = u.pm * BM + wr * 64 + fr; const int col0 = u.pn * BM + wc * 32 + 8 * fq; bf16_t* Ob = O;
        if (u.part >= 0) { Ob = PART + (size_t)u.part * 1024 * 1024; row0 -= 128 * BM; }
#pragma unroll
        for (int ai = 0; ai < 2; ++ai)
#pragma unroll
            for (int m = 0; m < 4; ++m) { bf16_t* rowp = Ob + (size_t)(row0 + ai * HALF + m * 16) * ldc + col0;
#pragma unroll
                for (int bj = 0; bj < 2; ++bj) { const f32x4 v0 = acc[ai][bj][m][0], v1 = acc[ai][bj][m][1];
                    u32x4 w; w.x = cvt_pk_bf16(v0[0], v0[1]); w.y = cvt_pk_bf16(v0[2], v0[3]); w.z = cvt_pk_bf16(v1[0], v1[1]); w.w = cvt_pk_bf16(v1[2], v1[3]);
                    if (col0 + bj * HALF < ncols) *(u32x4*)(rowp + bj * HALF) = w; } }
    }
};
__device__ __forceinline__ float silu_f(float x) { return x * __builtin_amdgcn_rcpf(1.0f + __builtin_amdgcn_exp2f(-1.4426950408889634f * x)); }
struct EpiSwiglu {
    static constexpr bool PERM = true;
    bf16_t* O; int ldc;
    __device__ __forceinline__ void operator()(const f32x4 (&acc)[2][2][4][2], const Unit& u, int wr, int wc, int fr, int fq) const {
        const int row0 = u.pm * BM + wr * 64 + fr; const int col0 = u.pn * HALF + wc * 32 + 8 * fq;
#pragma unroll
        for (int ai = 0; ai < 2; ++ai)
#pragma unroll
            for (int m = 0; m < 4; ++m) { bf16_t* rowp = O + (size_t)(row0 + ai * HALF + m * 16) * ldc + col0;
                const f32x4 g0 = acc[ai][0][m][0], g1 = acc[ai][0][m][1], u0 = acc[ai][1][m][0], u1 = acc[ai][1][m][1];
                u32x4 w; w.x = cvt_pk_bf16(silu_f(g0[0]) * u0[0], silu_f(g0[1]) * u0[1]); w.y = cvt_pk_bf16(silu_f(g0[2]) * u0[2], silu_f(g0[3]) * u0[3]);
                w.z = cvt_pk_bf16(silu_f(g1[0]) * u1[0], silu_f(g1[1]) * u1[1]); w.w = cvt_pk_bf16(silu_f(g1[2]) * u1[2], silu_f(g1[3]) * u1[3]);
                *(u32x4*)rowp = w; }
    }
};

template <class Epi>
__device__ __forceinline__ void gemm_phase(LAS unsigned char* lds, const Gemm g, const StaticOrder& S, const Epi& E) {
    const int tid = otid(), wid = __builtin_amdgcn_readfirstlane(tid >> 6), lane = tid & 63, wr = wid >> 2, wc = wid & 3, fr = lane & 15, fq = lane >> 4;
    unsigned voffA[2], voffB[2];
#pragma unroll
    for (int i = 0; i < 2; ++i) { int R, C; stage_rc(tid * 16 + i * 8192, R, C); const int Rb = Epi::PERM ? ((R & ~31) + perm32(R & 31)) : R;
        voffA[i] = (unsigned)(R * g.lda + C) * 2u; voffB[i] = (unsigned)(Rb * g.ldb + C) * 2u; }
    const size_t kstep = (size_t)(BK * 2);
    const size_t hsA = (size_t)HALF * g.lda * 2, hsB = (size_t)HALF * g.ldb * 2;
    const size_t tsA = 2 * hsA, tsB = 2 * hsB;
    const unsigned ldsw = (unsigned)wid * 1024u;
    const int aoff = lds_byte(wr * 64 + fr, fq * 8), boff = lds_byte(wc * 32 + fr, fq * 8);
#define PG8_SA(b, h) (((b) * 2 + (h)) * HTB)
#define PG8_SB(b, h) ((4 + (b) * 2 + (h)) * HTB)
#define PG8_STAGE(bufoff, gbase, voff) do { _Pragma("unroll") for (int _i = 0; _i < 2; ++_i) \
        __builtin_amdgcn_global_load_lds((const unsigned*)((const char*)(gbase) + (voff)[_i]), (LAS unsigned*)(lds + (bufoff) + ldsw + _i * 8192), 16, 0, 0); } while (0)
#define PG8_LDA(dst, b, h) do { _Pragma("unroll") for (int m = 0; m < 4; ++m) _Pragma("unroll") for (int k = 0; k < 2; ++k) dst[m][k] = *(const LAS bf16x8*)(lds + PG8_SA(b, h) + aoff + m * 2048 + k * 1024); } while (0)
#define PG8_LDB(dst, b, h) do { _Pragma("unroll") for (int n = 0; n < 2; ++n) _Pragma("unroll") for (int k = 0; k < 2; ++k) dst[n][k] = *(const LAS bf16x8*)(lds + PG8_SB(b, h) + boff + n * 2048 + k * 1024); } while (0)
#define PG8_MMA(ai, bj, At, Bt) do { __builtin_amdgcn_s_setprio(1); _Pragma("unroll") for (int m = 0; m < 4; ++m) _Pragma("unroll") for (int n = 0; n < 2; ++n) _Pragma("unroll") for (int k = 0; k < 2; ++k) \
        acc[ai][bj][m][n] = __builtin_amdgcn_mfma_f32_16x16x32_bf16(Bt[n][k], At[m][k], acc[ai][bj][m][n], 0, 0, 0); __builtin_amdgcn_s_setprio(0); } while (0)
#define PG8_WAIT_V(n) asm volatile("s_waitcnt vmcnt(" #n ")" ::: "memory")
#define PG8_WAIT_L(n) asm volatile("s_waitcnt lgkmcnt(" #n ")" ::: "memory")
#define PG8_BAR __builtin_amdgcn_s_barrier()
#define PG8_SCHED __builtin_amdgcn_sched_barrier(0)
    Unit cur, nxt; int ui = 0;
    if (!S.next(0, cur)) return;
    f32x4 acc[2][2][4][2];
#pragma unroll
    for (int a = 0; a < 2; ++a)
#pragma unroll
        for (int b = 0; b < 2; ++b)
#pragma unroll
            for (int m = 0; m < 4; ++m)
#pragma unroll
                for (int n = 0; n < 2; ++n) acc[a][b][m][n] = (f32x4){0.f, 0.f, 0.f, 0.f};
    bf16x8 At[4][2], B0[2][2], B1[2][2];
    const char* cA = (const char*)g.A + (size_t)cur.pm * tsA + (size_t)cur.kt0 * kstep; const char* cB = (const char*)g.Bt + (size_t)cur.pn * tsB + (size_t)cur.kt0 * kstep;
    PG8_STAGE(PG8_SB(0, 0), cB, voffB); PG8_STAGE(PG8_SB(0, 1), cB + hsB, voffB); PG8_STAGE(PG8_SA(0, 0), cA, voffA); PG8_STAGE(PG8_SA(0, 1), cA + hsA, voffA);
    if (wr == 1) PG8_BAR;
    PG8_WAIT_V(2); PG8_BAR;
    PG8_STAGE(PG8_SB(1, 0), cB + kstep, voffB); PG8_STAGE(PG8_SA(1, 0), cA + kstep, voffA); PG8_STAGE(PG8_SB(1, 1), cB + hsB + kstep, voffB);
    PG8_WAIT_V(6); PG8_BAR;
    for (;;) {
        const bool has_next = S.next(ui + 1, nxt);
        const char* nA = has_next ? (const char*)g.A + (size_t)nxt.pm * tsA + (size_t)nxt.kt0 * kstep : cA; const char* nB = has_next ? (const char*)g.Bt + (size_t)nxt.pn * tsB + (size_t)nxt.kt0 * kstep : cB;
        const int nt = cur.nt;
        for (int t = 0; t < nt; t += 2) {
            const bool last = (t == nt - 2);
            const char* a1 = cA + (size_t)(t + 1) * kstep;
            const char* a2 = last ? nA : cA + (size_t)(t + 2) * kstep; const char* b2 = last ? nB : cB + (size_t)(t + 2) * kstep;
            const char* a3 = a2 + kstep; const char* b3 = b2 + kstep;
            PG8_LDB(B0, 0, 0); PG8_LDB(B1, 0, 1); PG8_SCHED; PG8_LDA(At, 0, 0); PG8_STAGE(PG8_SA(1, 1), a1 + hsA, voffA);
            PG8_WAIT_V(8); PG8_WAIT_L(0); PG8_BAR; PG8_MMA(0, 0, At, B0); PG8_MMA(0, 1, At, B1); PG8_BAR; PG8_SCHED;
            PG8_LDA(At, 0, 1); PG8_STAGE(PG8_SB(0, 0), b2, voffB); PG8_STAGE(PG8_SB(0, 1), b2 + hsB, voffB); PG8_STAGE(PG8_SA(0, 0), a2, voffA);
            PG8_WAIT_V(8); PG8_WAIT_L(0); PG8_BAR; PG8_MMA(1, 0, At, B0); PG8_MMA(1, 1, At, B1); PG8_BAR; PG8_SCHED;
            PG8_LDB(B0, 1, 0); PG8_LDB(B1, 1, 1); PG8_SCHED; PG8_LDA(At, 1, 0); PG8_STAGE(PG8_SA(0, 1), a2 + hsA, voffA);
            PG8_WAIT_V(8); PG8_WAIT_L(0); PG8_BAR; PG8_MMA(0, 0, At, B0); PG8_MMA(0, 1, At, B1); PG8_BAR; PG8_SCHED;
            PG8_LDA(At, 1, 1); PG8_STAGE(PG8_SB(1, 0), b3, voffB); PG8_STAGE(PG8_SB(1, 1), b3 + hsB, voffB); PG8_STAGE(PG8_SA(1, 0), a3, voffA);
            PG8_WAIT_V(8); PG8_WAIT_L(0); PG8_BAR; PG8_MMA(1, 0, At, B0); PG8_MMA(1, 1, At, B1); PG8_BAR; PG8_SCHED;
        }
        if (wr == 0) PG8_BAR;
        E(acc, cur, wr, wc, fr, fq);
        if (!has_next) break;
#pragma unroll
        for (int a = 0; a < 2; ++a)
#pragma unroll
            for (int b = 0; b < 2; ++b)
#pragma unroll
                for (int m = 0; m < 4; ++m)
#pragma unroll
                    for (int n = 0; n < 2; ++n) acc[a][b][m][n] = (f32x4){0.f, 0.f, 0.f, 0.f};
        cur = nxt; cA = nA; cB = nB; ++ui;
        if (wr == 1) PG8_BAR;
    }
    PG8_WAIT_V(0);
    PG8_BAR;
#undef PG8_SA
#undef PG8_SB
#undef PG8_STAGE
#undef PG8_LDA
#undef PG8_LDB
#undef PG8_MMA
#undef PG8_WAIT_V
#undef PG8_WAIT_L
#undef PG8_BAR
#undef PG8_SCHED
}
}

__device__ __forceinline__ float bf2f(unsigned short h) { return __uint_as_float((unsigned)h << 16); }
__device__ __forceinline__ unsigned pk2(float lo, float hi) { return pg8::cvt_pk_bf16(lo, hi); }
__device__ __forceinline__ bf16_t f2bf(float f) { return (bf16_t)(pk2(f, 0.f) & 0xffffu); }
__device__ __forceinline__ float wave_sum(float v) {
#pragma unroll
    for (int o = 1; o < 64; o <<= 1) v += __shfl_xor(v, o);
    return v;
}
__device__ __forceinline__ int crow(int r, int hi) { return (r & 3) + 8 * (r >> 2) + 4 * hi; }
__device__ __forceinline__ float logsig16(float x) { return (fminf(x, 0.f) - __logf(1.0f + __expf(-fabsf(x)))) * 0.0625f; }

namespace fa {
#define SBAR() __builtin_amdgcn_sched_barrier(0)
#define KOFF(PITCH, row, colB) ((row) * (PITCH) + ((colB) ^ ((((row) >> 1) & 7) << 4)))
struct Args {
    const bf16_t* Q; int ldq;
    const bf16_t* K1; int ldk1; const bf16_t* K2; int ldk2; const bf16_t* V; int ldv;
    bf16_t* O; int ldo;
    int ctxrow0, latrow0, NT;
    float C, thr;
    const f32x2* rope; int pos0;
    const float* rpb; int masked; int r0, krow0;
};
__device__ __forceinline__ void partialSM(f32x16& p0, f32x16& p1, float& m_reg, float& mn, float& alpha, float C, float thr) {
    float pmax = p0[0];
#pragma unroll
    for (int r = 1; r < 16; ++r) pmax = fmaxf(pmax, p0[r]);
#pragma unroll
    for (int r = 0; r < 16; ++r) pmax = fmaxf(pmax, p1[r]);
    { auto rr = __builtin_amdgcn_permlane32_swap(__float_as_uint(pmax), __float_as_uint(pmax), false, false);
      pmax = fmaxf(__uint_as_float(rr[0]), __uint_as_float(rr[1])); }
    if (__builtin_expect(__all(pmax - m_reg <= thr), 1)) { mn = m_reg; alpha = 1.f; }
    else { mn = fmaxf(m_reg, pmax); alpha = __builtin_amdgcn_exp2f((m_reg - mn) * C); m_reg = mn; }
    const float mnC = -mn * C;
#pragma unroll
    for (int r = 0; r < 16; ++r) p0[r] = fmaf(p0[r], C, mnC);
#pragma unroll
    for (int r = 0; r < 16; ++r) p1[r] = fmaf(p1[r], C, mnC);
#pragma unroll
    for (int r = 0; r < 16; ++r) p0[r] = __builtin_amdgcn_exp2f(p0[r]);
}
__device__ __forceinline__ void finishSM(f32x16& p0, f32x16& p1, float alpha, float& l_reg, bf16x8& pa0, bf16x8& pa1, bf16x8& pa2, bf16x8& pa3) {
#pragma unroll
    for (int r = 0; r < 16; ++r) p1[r] = __builtin_amdgcn_exp2f(p1[r]);
    float ps = 0;
#pragma unroll
    for (int r = 0; r < 16; ++r) ps += p0[r];
#pragma unroll
    for (int r = 0; r < 16; ++r) ps += p1[r];
    { auto rr = __builtin_amdgcn_permlane32_swap(__float_as_uint(ps), __float_as_uint(ps), false, false);
      ps = __uint_as_float(rr[0]) + __uint_as_float(rr[1]); }
    l_reg = l_reg * alpha + ps;
#define PK4(P, BASE, OUT) do { unsigned a0 = pk2(P[BASE + 0], P[BASE + 1]), a1 = pk2(P[BASE + 2], P[BASE + 3]);   \
    unsigned b0 = pk2(P[BASE + 4], P[BASE + 5]), b1 = pk2(P[BASE + 6], P[BASE + 7]);                              \
    auto r0 = __builtin_amdgcn_permlane32_swap(a0, b0, false, false); auto r1 = __builtin_amdgcn_permlane32_swap(a1, b1, false, false); \
    u32x4 w = {r0[0], r1[0], r0[1], r1[1]}; OUT = *reinterpret_cast<bf16x8*>(&w); } while (0)
    PK4(p0, 0, pa0); PK4(p0, 8, pa1); PK4(p1, 0, pa2); PK4(p1, 8, pa3);
#undef PK4
}
template <int DQK> __device__ __forceinline__ void qkt(f32x16& p0, f32x16& p1, const char* Ks, const bf16x8* qr, int r32, int hi) {
    p0 = f32x16{}; p1 = f32x16{};
#pragma unroll
    for (int d0 = 0; d0 < DQK / 16; ++d0) { const int cb = (d0 * 16 + hi * 8) * 2;
        bf16x8 b0 = *reinterpret_cast<const bf16x8*>(Ks + KOFF(DQK * 2, r32, cb));
        bf16x8 b1 = *reinterpret_cast<const bf16x8*>(Ks + KOFF(DQK * 2, 32 + r32, cb));
        p0 = __builtin_amdgcn_mfma_f32_32x32x16_bf16(b0, qr[d0], p0, 0, 0, 0);
        p1 = __builtin_amdgcn_mfma_f32_32x32x16_bf16(b1, qr[d0], p1, 0, 0, 0); }
}
template <int NCB> __device__ __forceinline__ int v_st(int k, int c) { const int kk = (k & ~0xC) | ((k & 4) << 1) | ((k & 8) >> 1); return ((kk >> 3) * NCB + (c >> 5)) * 512 + ((kk & 7) * 32 + (c & 31)) * 2; }
__device__ __forceinline__ int v_rd_base(int lane) { return ((lane & 3) << 3) | (((lane >> 2) & 3) << 6) | (((lane >> 4) & 1) << 5) | (((lane >> 5) & 1) << 8); }
template <int OFF> __device__ __forceinline__ s16x4 tr_read(int vb) {
    s16x4 r; asm volatile("ds_read_b64_tr_b16 %0, %1 offset:%2" : "=&v"(r) : "v"(vb), "i"(OFF) : "memory"); return r;
}
template <int D0, int NCB> __device__ __forceinline__ void pv_one(f32x16& od, int vb, bf16x8 pa0, bf16x8 pa1, bf16x8 pa2, bf16x8 pa3) {
    constexpr int KS = NCB * 1024, HF = NCB * 512, B = D0 * 512;
    const s16x4 l0 = tr_read<B>(vb), h0 = tr_read<B + HF>(vb), l1 = tr_read<B + KS>(vb), h1 = tr_read<B + KS + HF>(vb);
    const s16x4 l2 = tr_read<B + 2 * KS>(vb), h2 = tr_read<B + 2 * KS + HF>(vb), l3 = tr_read<B + 3 * KS>(vb), h3 = tr_read<B + 3 * KS + HF>(vb);
    asm volatile("s_waitcnt lgkmcnt(0)" ::: "memory"); SBAR();
#define PK(L, H) (bf16x8){L[0], L[1], L[2], L[3], H[0], H[1], H[2], H[3]}
    od = __builtin_amdgcn_mfma_f32_32x32x16_bf16(pa0, PK(l0, h0), od, 0, 0, 0);
    od = __builtin_amdgcn_mfma_f32_32x32x16_bf16(pa1, PK(l1, h1), od, 0, 0, 0);
    od = __builtin_amdgcn_mfma_f32_32x32x16_bf16(pa2, PK(l2, h2), od, 0, 0, 0);
    od = __builtin_amdgcn_mfma_f32_32x32x16_bf16(pa3, PK(l3, h3), od, 0, 0, 0);
#undef PK
}
template <int DV> __device__ __forceinline__ void pv_all(f32x16* o, int vb, bf16x8 pa0, bf16x8 pa1, bf16x8 pa2, bf16x8 pa3) {
    constexpr int NCB = DV / 32;
    pv_one<0, NCB>(o[0], vb, pa0, pa1, pa2, pa3); pv_one<1, NCB>(o[1], vb, pa0, pa1, pa2, pa3);
    if constexpr (DV == 128) { pv_one<2, NCB>(o[2], vb, pa0, pa1, pa2, pa3); pv_one<3, NCB>(o[3], vb, pa0, pa1, pa2, pa3); }
}
__device__ __forceinline__ void na_mask(f32x16& p0, f32x16& p1, const float* tr, bool rowvalid, int cs, int hi) {
    if (!rowvalid) {
#pragma unroll
        for (int r = 0; r < 16; ++r) { p0[r] = -1e30f; p1[r] = -1e30f; }
    } else {
#pragma unroll
        for (int r = 0; r < 16; ++r) { const int kc0 = (r & 3) + 8 * (r >> 2); const int kc = kc0 + 4 * hi;
            const bool v0 = (unsigned)(kc - cs) < 16u, v1 = (unsigned)(kc + 32 - cs) < 16u;
            const float b0 = tr[kc0], b1 = tr[kc0 + 32];
            p0[r] = v0 ? p0[r] + b0 : -1e30f; p1[r] = v1 ? p1[r] + b1 : -1e30f; }
    }
}

template <int DQK, int DV, bool NA>
__device__ __forceinline__ void flash_unit(char* lds, const Args& A) {
    constexpr int NQ = DQK / 16, NO = DV / 32, NCB = DV / 32, KP = DQK * 2, SHM_K = 64 * KP, SHM_V = 64 * DV * 2;
    constexpr int KSL = DQK / 8, NKS = 64 * KSL / 512, VSL = DV / 8, NVS = 64 * VSL / 512, W1S = (DQK == 192 ? 16 : 8);
    const int tid = otid(), wid = tid >> 6, lane = tid & 63, r32 = lane & 31, hi = lane >> 5;
    char* V_lds = lds; char* K_lds = lds + 2 * SHM_V;
    float* wsf = (float*)(lds + 2 * SHM_V + 2 * SHM_K) + wid * 64; float* li_l = wsf; float* al_l = wsf + 32;
    float* tab = (float*)(lds + 2 * SHM_V + 2 * SHM_K + 2048);
    __syncthreads();
    if (NA && A.masked) { for (int i = tid; i < 465; i += 512) tab[64 + i] = A.rpb[i] * 8.f; }
    float m_reg = -1e30f, l_reg = 0; f32x16 o[NO]; bf16x8 qr[NQ];
#pragma unroll
    for (int d = 0; d < NO; ++d) o[d] = f32x16{};
    const bf16_t* Qw = A.Q + (long)(wid * 32 + r32) * A.ldq + hi * 8;
#pragma unroll
    for (int d0 = 0; d0 < NQ; ++d0) qr[d0] = *reinterpret_cast<const bf16x8*>(Qw + d0 * 16);
    if constexpr (!NA) {
        if (A.rope) {
            const f32x2* rt = A.rope + (long)(A.pos0 + wid * 32 + r32) * 32 + hi * 4;
#pragma unroll
            for (int d0 = 8; d0 < 12; ++d0) { bf16x8 v = qr[d0]; u32x4 w;
#pragma unroll
                for (int p = 0; p < 4; ++p) { const f32x2 cs = rt[(d0 - 8) * 8 + p]; const float x0 = bf2f((unsigned short)v[2 * p]), x1 = bf2f((unsigned short)v[2 * p + 1]);
                    w[p] = pk2(x0 * cs.x - x1 * cs.y, x0 * cs.y + x1 * cs.x); }
                qr[d0] = *reinterpret_cast<bf16x8*>(&w); }
        }
    }
    const int qgrow = A.r0 + (wid >> 1), rs = min(max(qgrow - 4, 0), 120), qc = (wid & 1) * 32 + r32, cs = min(max(qc - 8, 0), 48);
    const float* tabl = tab + 64 + 15 - qc + 4 * hi;
    const int vb0 = (int)(uintptr_t)V_lds + v_rd_base(lane);
    LAS unsigned char* Ll = (LAS unsigned char*)lds; const int widu = __builtin_amdgcn_readfirstlane(wid);
#define G0(j) ((j) < 4 ? A.ctxrow0 + 64 * (j) : A.latrow0 + 64 * ((j) - 4))
#define DMA(jt, b) do { const int g0_ = G0(jt); \
    _Pragma("unroll") for (int i = 0; i < NKS; ++i) { const int s_ = tid + 512 * i, row = s_ / KSL, c = (s_ % KSL) ^ ((row >> 1) & 7); const bf16_t* p_; \
        if (DQK == 192 && c >= W1S) p_ = A.K2 + (long)(g0_ + row) * A.ldk2 + (c - W1S) * 8; else p_ = A.K1 + (long)(g0_ + row) * A.ldk1 + c * 8; \
        __builtin_amdgcn_global_load_lds((const unsigned*)p_, (LAS unsigned*)(Ll + 2 * SHM_V + (b) * SHM_K + (i * 512 + widu * 64) * 16), 16, 0, 0); } \
    _Pragma("unroll") for (int i = 0; i < NVS; ++i) { const int off_ = (tid + 512 * i) * 16, st_ = off_ >> 9, wi_ = off_ & 511, kk_ = (st_ / NCB) * 8 + (wi_ >> 6); \
        const int k_ = (kk_ & ~0xC) | ((kk_ & 4) << 1) | ((kk_ & 8) >> 1), c_ = (st_ % NCB) * 32 + ((wi_ & 63) >> 1); \
        __builtin_amdgcn_global_load_lds((const unsigned*)(A.V + (long)(g0_ + k_) * A.ldv + c_), (LAS unsigned*)(Ll + (b) * SHM_V + (i * 512 + widu * 64) * 16), 16, 0, 0); } } while (0)
#define SWAIT() asm volatile("s_waitcnt vmcnt(0)" ::: "memory")
#define RESC(a) do { if (__any((a) < 1.f)) { if (hi == 0) al_l[r32] = (a); asm volatile("s_waitcnt lgkmcnt(0)" ::: "memory"); \
    _Pragma("unroll") for (int d = 0; d < NO; ++d) _Pragma("unroll") for (int r = 0; r < 16; ++r) o[d][r] *= al_l[crow(r, hi)]; } } while (0)
#define NAMASK(P0, P1, jt) do { if (NA) { if (A.masked && (jt) >= 4) { const int kr_ = A.krow0 + (jt) - 4; na_mask(P0, P1, tabl + (kr_ - qgrow + 7) * 31, (kr_ >= rs && kr_ < rs + 8), cs, hi); } } } while (0)
    f32x16 p0, p1; float mn, al; bf16x8 pa0, pa1, pa2, pa3; const int NT = A.NT;
    DMA(0, 0); SWAIT(); __syncthreads();
    for (int j = 0; j < NT; ++j) {
        const int buf = j & 1;
        if (j + 1 < NT) DMA(j + 1, buf ^ 1);
        bool act = true;
        if (NA) { if (A.masked && j >= 4) { const int kr_ = A.krow0 + j - 4; act = (kr_ >= rs && kr_ < rs + 8); } }
        if (act) {
        SBAR(); qkt<DQK>(p0, p1, K_lds + buf * SHM_K, qr, r32, hi); NAMASK(p0, p1, j);
        partialSM(p0, p1, m_reg, mn, al, A.C, A.thr);
        finishSM(p0, p1, al, l_reg, pa0, pa1, pa2, pa3); RESC(al); SBAR();
        pv_all<DV>(o, vb0 + buf * SHM_V, pa0, pa1, pa2, pa3);
        }
        SWAIT();
        __syncthreads();
    }
    if (hi == 0) li_l[r32] = l_reg; asm volatile("s_waitcnt lgkmcnt(0)" ::: "memory");
    float rli[16];
#pragma unroll
    for (int r = 0; r < 16; ++r) rli[r] = __builtin_amdgcn_rcpf(li_l[crow(r, hi)]);
    bf16_t* Ow = A.O + (long)(wid * 32) * A.ldo;
#pragma unroll
    for (int r = 0; r < 16; ++r) { const int orow = crow(r, hi);
#pragma unroll
        for (int d0 = 0; d0 < NO; ++d0) Ow[(long)orow * A.ldo + d0 * 32 + r32] = f2bf(o[d0][r] * rli[r]); }
#undef G0
#undef DMA
#undef SWAIT
#undef RESC
#undef NAMASK
}
}

struct KArgs { const float* in[24]; float* out; unsigned char* ws; int lo, hi; };
enum { I_X = 0, I_C, I_CTX, I_CCTX, I_ADAW, I_ADAB, I_F1IN, I_F1OUT, I_F2IN, I_F2OUT, I_EWIN, I_WG2F, I_BGF, I_WG2B, I_BGB, I_GLANG, I_QNG, I_KVNG, I_WUQ, I_WUKV, I_EWOUT, I_NWIN, I_RPB, I_NWOUT };

__device__ __forceinline__ void transpose_item(const float* W, int K, int N, bf16_t* WT, int swiglu, LAS float* scr, int item, int lane) {
    const int nblk = N / 32, kb = item / nblk, nb = item % nblk, k0 = 64 * kb, n0 = 32 * nb;
    int rbase = n0;
    if (swiglu) { const int half = N / 2; const int up = n0 >= half; const int nn = up ? n0 - half : n0; rbase = (nn >> 7) * 256 + up * 128 + (nn & 127); }
    { float tv[32];
#pragma unroll
      for (int i = 0; i < 32; ++i) tv[i] = W[(size_t)(k0 + 2 * i + (lane >> 5)) * N + n0 + (lane & 31)];
#pragma unroll
      for (int i = 0; i < 32; ++i) scr[(2 * i + (lane >> 5)) * 33 + (lane & 31)] = tv[i]; }
    asm volatile("s_waitcnt lgkmcnt(0)" ::: "memory");
    const int c = lane & 7;
#pragma unroll
    for (int j = 0; j < 4; ++j) { const int n = (lane >> 3) + 8 * j; const LAS float* s = scr + (8 * c) * 33 + n;
        u32x4 o; o.x = pk2(s[0 * 33], s[1 * 33]); o.y = pk2(s[2 * 33], s[3 * 33]); o.z = pk2(s[4 * 33], s[5 * 33]); o.w = pk2(s[6 * 33], s[7 * 33]);
        *(u32x4*)(WT + (size_t)(rbase + n) * K + k0 + 8 * c) = o; }
    asm volatile("s_waitcnt lgkmcnt(0)" ::: "memory");
}

__device__ __forceinline__ void convert_layer(const KArgs& a, int l, int gw, int NGW, LAS float* scr, int lane) {
    unsigned char* ws = optr(a.ws);
    constexpr int I_IN = 16 * 176, I_OUT = 44 * 32, I_L = 2 * (I_IN + I_OUT);
    constexpr int I_EIN = 16 * 67, I_UQ = 6 * 24, I_UKV = 2 * 32, I_SQ = 16 * 32, I_E = I_EIN + I_UQ + I_UKV + I_SQ;
    constexpr int I_NIN = 16 * 96, I_O = I_NIN + I_SQ;
    const int i = l >> 1; const int nit = I_L + ((l & 1) ? I_O : I_E);
    unsigned char* wl = ws + OFF_W + (size_t)l * WL_BYTES; unsigned char* we = ws + OFF_WE + (size_t)i * 8 * MiB; unsigned char* wo = ws + OFF_WO + (size_t)i * 8 * MiB;
    for (int it = gw; it < nit; it += NGW) {
        int r = it;
        if (r < I_L) {
            if (r < I_IN) { transpose_item(a.in[I_F1IN] + (size_t)l * DM * 2 * DFF, DM, 2 * DFF, (bf16_t*)wl, 1, scr, r, lane); continue; } r -= I_IN;
            if (r < I_OUT) { transpose_item(a.in[I_F1OUT] + (size_t)l * DFF * DM, DFF, DM, (bf16_t*)(wl + W1OUT_O), 0, scr, r, lane); continue; } r -= I_OUT;
            if (r < I_IN) { transpose_item(a.in[I_F2IN] + (size_t)l * DM * 2 * DFF, DM, 2 * DFF, (bf16_t*)(wl + W2IN_O), 1, scr, r, lane); continue; } r -= I_IN;
            transpose_item(a.in[I_F2OUT] + (size_t)l * DFF * DM, DFF, DM, (bf16_t*)(wl + W2OUT_O), 0, scr, r, lane); continue; }
        r -= I_L;
        if (!(l & 1)) {
            if (r < I_EIN) { transpose_item(a.in[I_EWIN] + (size_t)i * DM * PW, DM, PW, (bf16_t*)we, 0, scr, r, lane); continue; } r -= I_EIN;
            if (r < I_UQ) { transpose_item(a.in[I_WUQ] + (size_t)i * 384 * 768, 384, 768, (bf16_t*)(we + WUQ_O), 0, scr, r, lane); continue; } r -= I_UQ;
            if (r < I_UKV) { transpose_item(a.in[I_WUKV] + (size_t)i * 128 * 1024, 128, 1024, (bf16_t*)(we + WUKV_O), 0, scr, r, lane); continue; } r -= I_UKV;
            transpose_item(a.in[I_EWOUT] + (size_t)i * DM * DM, DM, DM, (bf16_t*)(we + WEO_O), 0, scr, r, lane); }
        else {
            if (r < I_NIN) { transpose_item(a.in[I_NWIN] + (size_t)i * DM * 3072, DM, 3072, (bf16_t*)wo, 0, scr, r, lane); continue; } r -= I_NIN;
            transpose_item(a.in[I_NWOUT] + (size_t)i * DM * DM, DM, DM, (bf16_t*)(wo + WNO_O), 0, scr, r, lane); }
    }
}

__device__ __forceinline__ void phase_prep(const KArgs& a, unsigned char* lds_g) {
    unsigned char* wsq = optr(a.ws);
    LAS unsigned char* lds = (LAS unsigned char*)lds_g;
    const int tid = otid(), lane = tid & 63, wave = tid >> 6, G = gridDim.x;
    unsigned char* ws = wsq;
    convert_layer(a, 0, obid() * 8 + wave, G * 8, (LAS float*)(lds + wave * 16384), lane);
    {
        float* par = (float*)(ws + OFF_PAR); const int g0 = obid() * 512 + tid, gs = G * 512;
        for (int i = g0; i < 768; i += gs) par[PQ_QNG + i] = a.in[I_QNG][i];
        for (int i = g0; i < 256; i += gs) { par[PQ_KVNG + i] = a.in[I_KVNG][i]; par[PQ_GLANG + i] = a.in[I_GLANG][i]; }
        for (int i = g0; i < 8192; i += gs) { par[PQ_WG2F + i] = a.in[I_WG2F][i]; par[PQ_WG2B + i] = a.in[I_WG2B][i]; }
        for (int i = g0; i < 512; i += gs) { par[PQ_BGF + i] = a.in[I_BGF][i]; par[PQ_BGB + i] = a.in[I_BGB][i]; }
        for (int i = g0; i < 14880; i += gs) par[PQ_RPB + i] = a.in[I_RPB][i];
    }
    {
        f32x2* rope = (f32x2*)(ws + OFF_ROPE);
        for (int idx = obid() * 512 + tid; idx < SEQ * 32; idx += G * 512) {
            const int t = idx >> 5, i = idx & 31; const float pos = (float)((i < 16) ? (t >> 6) : (t & 63));
            const float inv = powf(10000.0f, -(float)(i & 15) / 16.0f); const float ang = pos * inv;
            rope[idx] = (f32x2){cosf(ang), sinf(ang)};
        }
    }
    __syncthreads();
    {
        LAS float* sl = (LAS float*)lds;
        LAS float* red = (LAS float*)(lds + 20480);
        for (int i = tid; i < 5 * 1024; i += 512) { const int r = i >> 10, k = i & 1023; const float v = (r < 4) ? a.in[I_C][r * 1024 + k] : a.in[I_CCTX][k]; sl[i] = v / (1.0f + __expf(-v)); }
        __syncthreads();
        float* mod = (float*)(ws + OFF_MOD);
        for (int item = obid(); item < 4 * 144; item += G) {
            const int l = item / 144, g = item % 144, col = tid & 63, ks = tid >> 6;
            const float* w = a.in[I_ADAW] + ((size_t)l * 1024 + ks * 128) * 9216 + g * 64 + col;
            const LAS float* s = sl + ks * 128;
            float a0 = 0, a1 = 0, a2 = 0, a3 = 0, a4 = 0;
            for (int k0 = 0; k0 < 128; k0 += 32) { float wv[32];
#pragma unroll
                for (int k = 0; k < 32; ++k) wv[k] = w[(size_t)(k0 + k) * 9216];
#pragma unroll
                for (int k = 0; k < 32; ++k) { a0 += s[k0 + k] * wv[k]; a1 += s[1024 + k0 + k] * wv[k]; a2 += s[2048 + k0 + k] * wv[k]; a3 += s[3072 + k0 + k] * wv[k]; a4 += s[4096 + k0 + k] * wv[k]; } }
            red[(ks * 5 + 0) * 64 + col] = a0; red[(ks * 5 + 1) * 64 + col] = a1; red[(ks * 5 + 2) * 64 + col] = a2; red[(ks * 5 + 3) * 64 + col] = a3; red[(ks * 5 + 4) * 64 + col] = a4;
            __syncthreads();
            if (tid < 320) { const int r = tid >> 6; float sum = a.in[I_ADAB][l * 9216 + g * 64 + col];
#pragma unroll
                for (int q = 0; q < 8; ++q) sum += red[(q * 5 + r) * 64 + col];
                mod[(size_t)(l * 5 + r) * 9216 + g * 64 + col] = sum; }
            __syncthreads();
        }
    }
}

__device__ __forceinline__ void phase_init_h(const KArgs& a) {
    unsigned char* wsq = optr(a.ws);
    const int lane = otid() & 63, gw = obid() * 8 + (otid() >> 6), NGW = gridDim.x * 8;
    const float* mod = (const float*)(wsq + OFF_MOD); bf16_t* Hb = (bf16_t*)(wsq + OFF_HB);
    f32x4 xv[4], nx[4];
#define IH_LOAD(XV, row_) do { const int r_ = (row_); const float* xs_ = (r_ < ML) ? a.in[I_X] + (size_t)r_ * DM : a.in[I_CTX] + (size_t)(r_ - ML) * DM; \
        _Pragma("unroll") for (int j = 0; j < 4; ++j) XV[j] = *(const f32x4*)(xs_ + 4 * lane + 256 * j); } while (0)
    if (gw < MR) IH_LOAD(xv, gw);
    for (int row = gw; row < MR; row += NGW) {
        if (row + NGW < MR) IH_LOAD(nx, row + NGW);
        const int rr = (row < ML) ? (row >> 13) : 4;
        const float* sh = mod + (size_t)rr * 9216; const float* sc = sh + 1024;
#pragma unroll
        for (int j = 0; j < 4; ++j) { const int c = 4 * lane + 256 * j; const f32x4 s1 = *(const f32x4*)(sc + c), s0 = *(const f32x4*)(sh + c);
            const f32x4 h = xv[j] * (1.0f + s1) + s0; u32x2 w; w.x = pk2(h[0], h[1]); w.y = pk2(h[2], h[3]); *(u32x2*)(Hb + (size_t)row * DM + c) = w; }
#pragma unroll
        for (int j = 0; j < 4; ++j) xv[j] = nx[j];
    }
#undef IH_LOAD
}

__device__ __forceinline__ void phase_ln(const float* xl_src, const float* xc_src, float* xl_dst, float* xc_dst, const bf16_t* Y, int ldy,
                                         const float* modg, float coef, const float* modh, bf16_t* Hb, const bf16_t* PART, int nparts) {
    const int lane = otid() & 63, gw = obid() * 8 + (otid() >> 6), NGW = gridDim.x * 8;
    f32x4 xv[4], nxv[4]; u32x2 yv[4], nyv[4]; f32x4 gq[4], s0q[4], s1q[4]; int cur_rr = -1;
#pragma unroll
    for (int j = 0; j < 4; ++j) { gq[j] = (f32x4){0.f, 0.f, 0.f, 0.f}; s0q[j] = gq[j]; s1q[j] = gq[j]; }
#define LN_LOAD(XV, YV, row_) do { const int r_ = (row_); const bool lat_ = r_ < ML; \
        const float* xs_ = lat_ ? xl_src + (size_t)r_ * DM : xc_src + (size_t)(r_ - ML) * DM; const bf16_t* y_ = Y + (size_t)r_ * ldy; \
        _Pragma("unroll") for (int j = 0; j < 4; ++j) { const int c = 4 * lane + 256 * j; XV[j] = *(const f32x4*)(xs_ + c); YV[j] = *(const u32x2*)(y_ + c); } } while (0)
    if (gw < MR) LN_LOAD(xv, yv, gw);
    for (int row = gw; row < MR; row += NGW) {
        const bool lat = row < ML; const int rr = lat ? (row >> 13) : 4;
        if (row + NGW < MR) LN_LOAD(nxv, nyv, row + NGW);
        float* xd = lat ? xl_dst + (size_t)row * DM : xc_dst + (size_t)(row - ML) * DM;
        if (rr != cur_rr) { cur_rr = rr;
#pragma unroll
            for (int j = 0; j < 4; ++j) { const int c = 4 * lane + 256 * j; gq[j] = *(const f32x4*)(modg + (size_t)rr * 9216 + c) * coef;
                if (modh) { s0q[j] = *(const f32x4*)(modh + (size_t)rr * 9216 + c); s1q[j] = *(const f32x4*)(modh + (size_t)rr * 9216 + 1024 + c) + 1.0f; } } }
        f32x4 t[4]; float s = 0.f;
#pragma unroll
        for (int j = 0; j < 4; ++j) { const int c = 4 * lane + 256 * j; const f32x4 gg = gq[j]; const u32x2 yw = yv[j];
            f32x4 yy;
            if (lat) { yy[0] = __uint_as_float(yw.x << 16); yy[1] = __uint_as_float(yw.x & 0xffff0000u); yy[2] = __uint_as_float(yw.y << 16); yy[3] = __uint_as_float(yw.y & 0xffff0000u); }
            else { yy = (f32x4){0.f, 0.f, 0.f, 0.f};
                u32x2 pw[11];
#pragma unroll
                for (int p = 0; p < 11; ++p) { pw[p] = (u32x2){0u, 0u}; if (p < nparts) pw[p] = *(const u32x2*)(PART + ((size_t)p * 1024 + (row - ML)) * 1024 + c); }
#pragma unroll
                for (int p = 0; p < 11; ++p) { yy[0] += __uint_as_float(pw[p].x << 16); yy[1] += __uint_as_float(pw[p].x & 0xffff0000u); yy[2] += __uint_as_float(pw[p].y << 16); yy[3] += __uint_as_float(pw[p].y & 0xffff0000u); } }
            t[j] = xv[j] * ALPHA + gg * yy; s += (t[j][0] + t[j][1]) + (t[j][2] + t[j][3]); }
        const float mean = wave_sum(s) * (1.0f / DM); float s2 = 0.f;
#pragma unroll
        for (int j = 0; j < 4; ++j) { t[j] = t[j] - mean; s2 += (t[j][0] * t[j][0] + t[j][1] * t[j][1]) + (t[j][2] * t[j][2] + t[j][3] * t[j][3]); }
        const float rstd = 1.0f / sqrtf(wave_sum(s2) * (1.0f / DM) + LN_EPS);
#pragma unroll
        for (int j = 0; j < 4; ++j) { const int c = 4 * lane + 256 * j; const f32x4 xn = t[j] * rstd; *(f32x4*)(xd + c) = xn;
            if (modh) { const f32x4 h = xn * s1q[j] + s0q[j];
                u32x2 w; w.x = pk2(h[0], h[1]); w.y = pk2(h[2], h[3]); *(u32x2*)(Hb + (size_t)row * DM + c) = w; } }
#pragma unroll
        for (int j = 0; j < 4; ++j) { xv[j] = nxv[j]; yv[j] = nyv[j]; }
    }
#undef LN_LOAD
}

__device__ __forceinline__ void phase_evenD(bf16_t* P, const float* qng, const float* kvng, const f32x2* rope) {
    const int lane = otid() & 63, gw = obid() * 8 + (otid() >> 6), NGW = gridDim.x * 8;
    const float g0 = qng[2 * lane], g1 = qng[2 * lane + 1], g2 = qng[2 * lane + 128], g3 = qng[2 * lane + 129], g4 = qng[2 * lane + 256], g5 = qng[2 * lane + 257];
    const float k0 = kvng[2 * lane], k1 = kvng[2 * lane + 1];
    unsigned w0, w1, w2, wk, wr; f32x2 cs; unsigned n0, n1, n2, nk, nr; f32x2 ncs;
#define ED_LOAD(W0, W1, W2, WK, WR, CS, row_) do { const bf16_t* p_ = P + (size_t)(row_) * PW; W0 = *(const unsigned*)(p_ + PC_CQ + 2 * lane); W1 = *(const unsigned*)(p_ + PC_CQ + 2 * lane + 128); \
        W2 = *(const unsigned*)(p_ + PC_CQ + 2 * lane + 256); WK = *(const unsigned*)(p_ + PC_CKV + 2 * lane); WR = *(const unsigned*)(p_ + PC_KR + 2 * (lane & 31)); \
        CS = rope[(size_t)((row_) & (SEQ - 1)) * 32 + (lane & 31)]; } while (0)
    if (gw < MR) ED_LOAD(w0, w1, w2, wk, wr, cs, gw);
    for (int row = gw; row < MR; row += NGW) {
        if (row + NGW < MR) ED_LOAD(n0, n1, n2, nk, nr, ncs, row + NGW);
        bf16_t* pr = P + (size_t)row * PW;
        { const float x0 = __uint_as_float(w0 << 16), x1 = __uint_as_float(w0 & 0xffff0000u), x2 = __uint_as_float(w1 << 16), x3 = __uint_as_float(w1 & 0xffff0000u), x4 = __uint_as_float(w2 << 16), x5 = __uint_as_float(w2 & 0xffff0000u);
          const float y0 = __uint_as_float(wk << 16), y1 = __uint_as_float(wk & 0xffff0000u);
          float ss = (x0 * x0 + x1 * x1) + (x2 * x2 + x3 * x3) + (x4 * x4 + x5 * x5), sk = y0 * y0 + y1 * y1;
#pragma unroll
          for (int o = 1; o < 64; o <<= 1) { ss += __shfl_xor(ss, o); sk += __shfl_xor(sk, o); }
          const float rs = __builtin_amdgcn_rsqf(ss * (1.0f / 384.0f) + LN_EPS), rk = __builtin_amdgcn_rsqf(sk * (1.0f / 128.0f) + LN_EPS);
          *(unsigned*)(pr + PC_CQ + 2 * lane) = pk2(x0 * rs * g0, x1 * rs * g1); *(unsigned*)(pr + PC_CQ + 2 * lane + 128) = pk2(x2 * rs * g2, x3 * rs * g3); *(unsigned*)(pr + PC_CQ + 2 * lane + 256) = pk2(x4 * rs * g4, x5 * rs * g5);
          *(unsigned*)(pr + PC_CKV + 2 * lane) = pk2(y0 * rk * k0, y1 * rk * k1); }
        if (row < ML && lane < 32) { const float x0 = __uint_as_float(wr << 16), x1 = __uint_as_float(wr & 0xffff0000u);
          *(unsigned*)(pr + PC_KR + 2 * lane) = pk2(x0 * cs.x - x1 * cs.y, x0 * cs.y + x1 * cs.x); }
        w0 = n0; w1 = n1; w2 = n2; wk = nk; wr = nr; cs = ncs;
    }
#undef ED_LOAD
}

__device__ __forceinline__ f32x16 mma_nt(const bf16_t* X, int ldx, const bf16_t* Y, int ldy, int nk, f32x16 acc, int r32, int hi) {
    for (int kk = 0; kk < nk; ++kk) { const bf16x8 a = *(const bf16x8*)(X + r32 * ldx + kk * 16 + hi * 8); const bf16x8 b = *(const bf16x8*)(Y + r32 * ldy + kk * 16 + hi * 8);
        acc = __builtin_amdgcn_mfma_f32_32x32x16_bf16(a, b, acc, 0, 0, 0); }
    return acc;
}
__device__ __forceinline__ int chunk_row0(int b, int cid) { return cid < 4 ? ML + b * CTXL + cid * 64 : b * SEQ + (cid - 4) * 64; }

#define LBAR() do { asm volatile("s_waitcnt lgkmcnt(0)" ::: "memory"); __builtin_amdgcn_s_barrier(); asm volatile("" ::: "memory"); } while (0)
__device__ __forceinline__ void gla_gates(const float* par, int ie, int h, int tid, const float* lrs, float* gs, float* qs) {
    const int dir = (tid >> 6) & 1, d = tid & 63, tq = tid >> 7;
    const float* wg = par + (dir ? PQ_WG2B : PQ_WG2F) + ie * 16 * 256 + h * 64 + d; const float bias = par[(dir ? PQ_BGB : PQ_BGF) + ie * 256 + h * 64 + d];
    float w[16];
#pragma unroll
    for (int j = 0; j < 16; ++j) w[j] = wg[j * 256];
    float run = 0.f;
#pragma unroll 4
    for (int tt = 0; tt < 16; ++tt) { const int t = tq * 16 + (dir ? 15 - tt : tt); float x = bias;
        const f32x4* lr4 = (const f32x4*)(lrs + t * 32 + dir * 16);
#pragma unroll
        for (int j4 = 0; j4 < 4; ++j4) { const f32x4 l = lr4[j4]; x += l[0] * w[4 * j4] + l[1] * w[4 * j4 + 1] + l[2] * w[4 * j4 + 2] + l[3] * w[4 * j4 + 3]; }
        run += logsig16(x); gs[(dir * 64 + t) * 64 + d] = run; }
    qs[(dir * 64 + d) * 4 + tq] = run;
}
__device__ __forceinline__ float gla_offset(const float* qs, int dir, int d, int tq, float& tot) {
    const f32x4 q = *(const f32x4*)(qs + (dir * 64 + d) * 4); tot = (q[0] + q[1]) + (q[2] + q[3]);
    float off = 0.f;
    if (dir == 0) { if (tq > 0) off += q[0]; if (tq > 1) off += q[1]; if (tq > 2) off += q[2]; }
    else { if (tq < 3) off += q[3]; if (tq < 2) off += q[2]; if (tq < 1) off += q[1]; }
    return off;
}
#define GLA_DECODE(uu, h_, cid_, b_, row0_) const int h_ = (uu) & 3, cid_ = ((uu) >> 2) % NCH, b_ = (uu) / (4 * NCH); const int row0_ = chunk_row0(b_, cid_)
__device__ __forceinline__ void phase_gla_c1(const KArgs& a, int ie, char* lds) {
    unsigned char* wsq = optr(a.ws);
    const float* par = (const float*)(wsq + OFF_PAR);
    const int tid = otid(), wid = tid >> 6, lane = tid & 63, r32 = lane & 31, hi = lane >> 5;
    const bf16_t* P = (const bf16_t*)(wsq + OFF_R); bf16_t* SL = (bf16_t*)(wsq + OFF_R + R_SL); float* DEC = (float*)(wsq + OFF_R + R_DEC);
    float* lrs = (float*)lds; float* gs = (float*)(lds + 8192); bf16_t* kdT = (bf16_t*)(lds + 40960); bf16_t* vT = (bf16_t*)(lds + 59392); bf16_t* Ks = (bf16_t*)(lds + 77824); float* qs = (float*)(lds + 86016);
    const int NU = NB * NCH * 4, G = gridDim.x;
    bf16x8 pk, pv0, pv1, plv;
#define C1_LOAD(uu) do { GLA_DECODE(uu, h_, cid_, b_, row0_); (void)cid_; (void)b_; \
        pk = *(const bf16x8*)(P + (size_t)(row0_ + (tid >> 3)) * PW + PC_K + h_ * 64 + (tid & 7) * 8); \
        pv0 = *(const bf16x8*)(P + (size_t)(row0_ + (tid & 63)) * PW + PC_V + h_ * 128 + (tid >> 6) * 8); \
        pv1 = *(const bf16x8*)(P + (size_t)(row0_ + (tid & 63)) * PW + PC_V + h_ * 128 + 64 + (tid >> 6) * 8); \
        plv = *(const bf16x8*)(P + (size_t)(row0_ + ((tid & 255) >> 2)) * PW + PC_LRF + (tid & 3) * 8); } while (0)
    int u = obid();
    if (u < NU) C1_LOAD(u);
    for (; u < NU; u += G) {
        GLA_DECODE(u, h, cid, b, row0); (void)row0;
        LBAR();
        *(bf16x8*)(Ks + tid * 8) = pk;
#pragma unroll
        for (int q = 0; q < 8; ++q) { vT[((tid >> 6) * 8 + q) * 72 + (tid & 63)] = (bf16_t)pv0[q]; vT[(64 + (tid >> 6) * 8 + q) * 72 + (tid & 63)] = (bf16_t)pv1[q]; }
        if (tid < 256) {
#pragma unroll
            for (int q = 0; q < 8; ++q) lrs[tid * 8 + q] = bf2f((unsigned short)plv[q]); }
        if (u + G < NU) C1_LOAD(u + G);
        LBAR();
        gla_gates(par, ie, h, tid, lrs, gs, qs);
        LBAR();
        { const int dir = (tid >> 6) & 1, d = tid & 63, tq = tid >> 7; float tot; const float off = gla_offset(qs, dir, d, tq, tot);
#pragma unroll 4
          for (int tt = 0; tt < 16; ++tt) { const int t = tq * 16 + tt; const float run = gs[(dir * 64 + t) * 64 + d] + off;
              kdT[(dir * 64 + d) * 72 + t] = f2bf(bf2f(Ks[t * 64 + d]) * __expf(tot - run)); }
          if (tq == 0) DEC[((size_t)((b * 2 + dir) * 4 + h) * NCH + cid) * 64 + d] = __expf(tot); }
        LBAR();
#pragma unroll
        for (int q = 0; q < 2; ++q) { const int ti = wid + 8 * q, dir = ti >> 3, ct = (ti >> 1) & 3, dt = ti & 1;
            f32x16 acc = f32x16{}; acc = mma_nt(vT + ct * 32 * 72, 72, kdT + (dir * 64 + dt * 32) * 72, 72, 4, acc, r32, hi);
            bf16_t* dst = SL + ((size_t)((b * 2 + dir) * 4 + h) * NCH + cid) * 8192;
#pragma unroll
            for (int r = 0; r < 16; ++r) dst[(ct * 32 + crow(r, hi)) * 64 + dt * 32 + r32] = f2bf(acc[r]); }
    }
    LBAR();
#undef C1_LOAD
}
__device__ __forceinline__ void phase_gla_c2(const KArgs& a) {
    unsigned char* wsq = optr(a.ws);
    bf16_t* SL = (bf16_t*)(wsq + OFF_R + R_SL); const float* DEC = (const float*)(wsq + OFF_R + R_DEC);
    for (int gid = obid() * 512 + otid(); gid < 32 * 4096; gid += gridDim.x * 512) {
        const int bdh = gid >> 12, e = (gid & 4095) * 2, d = e & 63, dir = (bdh >> 2) & 1;
        float S0 = 0.f, S1 = 0.f;
        unsigned loc[12], nloc[12]; f32x2 dd[12], ndd[12];
#define C2_LOAD(L, D, s0_) do { _Pragma("unroll") for (int q = 0; q < 12; ++q) { const int s = (s0_) + q; const int cid = dir ? (s < 4 ? 3 - s : 135 - s) : s; const size_t idx = (size_t)bdh * NCH + cid; \
            L[q] = *(const unsigned*)(SL + idx * 8192 + e); D[q] = *(const f32x2*)(DEC + idx * 64 + d); } } while (0)
        C2_LOAD(loc, dd, 0);
        for (int s0 = 0; s0 < NCH; s0 += 12) {
            if (s0 + 12 < NCH) C2_LOAD(nloc, ndd, s0 + 12);
#pragma unroll
            for (int q = 0; q < 12; ++q) { const int s = s0 + q; const int cid = dir ? (s < 4 ? 3 - s : 135 - s) : s; const size_t idx = (size_t)bdh * NCH + cid;
                *(unsigned*)(SL + idx * 8192 + e) = pk2(S0, S1); S0 = S0 * dd[q].x + __uint_as_float(loc[q] << 16); S1 = S1 * dd[q].y + __uint_as_float(loc[q] & 0xffff0000u); }
#pragma unroll
            for (int q = 0; q < 12; ++q) { loc[q] = nloc[q]; dd[q] = ndd[q]; }
        }
#undef C2_LOAD
    }
}
__device__ __forceinline__ void phase_gla_c3(const KArgs& a, int ie, char* lds) {
    unsigned char* wsq = optr(a.ws);
    const float* par = (const float*)(wsq + OFF_PAR);
    const int tid = otid(), wid = tid >> 6, lane = tid & 63, r32 = lane & 31, hi = lane >> 5;
    const bf16_t* P = (const bf16_t*)(wsq + OFF_R); const bf16_t* SL = (const bf16_t*)(wsq + OFF_R + R_SL); bf16_t* CAT = (bf16_t*)(wsq + OFF_HB);
    float* lrs = (float*)lds; bf16_t* QE = (bf16_t*)(lds + 8192); bf16_t* KE = (bf16_t*)(lds + 25600); bf16_t* VT = (bf16_t*)(lds + 44032);
    bf16_t* ST = (bf16_t*)(lds + 62464); float* gs = (float*)(lds + 62464);
    bf16_t* AM = (bf16_t*)(lds + 97280); float* part = (float*)(lds + 106496); bf16_t* Ks = (bf16_t*)(lds + 107520); bf16_t* Qs = (bf16_t*)(lds + 115712); float* qs = (float*)(lds + 123904);
    const float* ng = par + PQ_GLANG + ie * 128;
    const int NU = NB * NCH * 4, G = gridDim.x;
    const int oit = wid >> 2, oct = wid & 3;
    bf16x8 pk, pq, pv0, pv1, plv, psv[4]; bf16_t prg[16];
#define C3_LOAD_A(uu) do { GLA_DECODE(uu, h_, cid_, b_, row0_); (void)cid_; (void)b_; \
        pk = *(const bf16x8*)(P + (size_t)(row0_ + (tid >> 3)) * PW + PC_K + h_ * 64 + (tid & 7) * 8); \
        pq = *(const bf16x8*)(P + (size_t)(row0_ + (tid >> 3)) * PW + PC_Q + h_ * 64 + (tid & 7) * 8); \
        pv0 = *(const bf16x8*)(P + (size_t)(row0_ + (tid & 63)) * PW + PC_V + h_ * 128 + (tid >> 6) * 8); \
        pv1 = *(const bf16x8*)(P + (size_t)(row0_ + (tid & 63)) * PW + PC_V + h_ * 128 + 64 + (tid >> 6) * 8); \
        plv = *(const bf16x8*)(P + (size_t)(row0_ + ((tid & 255) >> 2)) * PW + PC_LRF + (tid & 3) * 8); } while (0)
#define C3_LOAD_B(uu) do { GLA_DECODE(uu, h_, cid_, b_, row0_); \
        _Pragma("unroll") for (int q = 0; q < 4; ++q) { const int i = tid + 512 * q, dir = i >> 10, c = (i >> 3) & 127, d8 = (i & 7) * 8; \
            psv[q] = *(const bf16x8*)(SL + ((size_t)((b_ * 2 + dir) * 4 + h_) * NCH + cid_) * 8192 + c * 64 + d8); } \
        _Pragma("unroll") for (int r = 0; r < 16; ++r) prg[r] = P[(size_t)(row0_ + oit * 32 + crow(r, hi)) * PW + PC_R + h_ * 128 + oct * 32 + r32]; } while (0)
    int u = obid();
    if (u < NU) { C3_LOAD_A(u); C3_LOAD_B(u); }
    for (; u < NU; u += G) {
        GLA_DECODE(u, h, cid, b, row0); (void)cid; (void)b;
        bf16_t crg[16];
#pragma unroll
        for (int r = 0; r < 16; ++r) crg[r] = prg[r];
        LBAR();
        *(bf16x8*)(Ks + tid * 8) = pk; *(bf16x8*)(Qs + tid * 8) = pq;
#pragma unroll
        for (int q = 0; q < 8; ++q) { VT[((tid >> 6) * 8 + q) * 72 + (tid & 63)] = (bf16_t)pv0[q]; VT[(64 + (tid >> 6) * 8 + q) * 72 + (tid & 63)] = (bf16_t)pv1[q]; }
        if (tid < 256) {
#pragma unroll
            for (int q = 0; q < 8; ++q) lrs[tid * 8 + q] = bf2f((unsigned short)plv[q]); }
        if (u + G < NU) C3_LOAD_A(u + G);
        LBAR();
        gla_gates(par, ie, h, tid, lrs, gs, qs);
        LBAR();
        { const int dir = (tid >> 6) & 1, d = tid & 63, tq = tid >> 7; float tot; const float off = gla_offset(qs, dir, d, tq, tot); (void)tot;
#pragma unroll 4
          for (int tt = 0; tt < 16; ++tt) { const int t = tq * 16 + tt; const float run = gs[(dir * 64 + t) * 64 + d] + off;
              const float q = bf2f(Qs[t * 64 + d]) * 0.125f, k = bf2f(Ks[t * 64 + d]);
              QE[t * 136 + dir * 64 + d] = f2bf(q * __expf(run)); KE[(dir * 64 + t) * 72 + d] = f2bf(k * __expf(-run)); } }
        LBAR();
#pragma unroll
        for (int q = 0; q < 4; ++q) { const int i = tid + 512 * q, dir = i >> 10, c = (i >> 3) & 127, d8 = (i & 7) * 8; *(bf16x8*)(ST + c * 136 + dir * 64 + d8) = psv[q]; }
        { const int tile = wid & 3, dir = wid >> 2, it = tile >> 1, jt = tile & 1;
          f32x16 acc = f32x16{}; acc = mma_nt(QE + it * 32 * 136 + dir * 64, 136, KE + (dir * 64 + jt * 32) * 72, 72, 4, acc, r32, hi);
#pragma unroll
          for (int r = 0; r < 16; ++r) { const int i = it * 32 + crow(r, hi), j = jt * 32 + r32; const bool own = dir ? (i < j) : (i >= j); if (own) AM[i * 72 + j] = f2bf(acc[r]); } }
        if (u + G < NU) C3_LOAD_B(u + G);
        LBAR();
        { const int it = oit, ct = oct;
          f32x16 acc = f32x16{}; acc = mma_nt(AM + it * 32 * 72, 72, VT + ct * 32 * 72, 72, 4, acc, r32, hi);
          acc = mma_nt(QE + it * 32 * 136, 136, ST + ct * 32 * 136, 136, 8, acc, r32, hi);
          float ss[16];
#pragma unroll
          for (int r = 0; r < 16; ++r) { float v = acc[r] * acc[r]; v += __shfl_xor(v, 1); v += __shfl_xor(v, 2); v += __shfl_xor(v, 4); v += __shfl_xor(v, 8); v += __shfl_xor(v, 16); ss[r] = v; }
          if (r32 == 0) {
#pragma unroll
              for (int r = 0; r < 16; ++r) part[ct * 64 + it * 32 + crow(r, hi)] = ss[r]; }
          const int c = ct * 32 + r32; const float gn = ng[c];
          LBAR();
#pragma unroll
          for (int r = 0; r < 16; ++r) { const int i = it * 32 + crow(r, hi); const float tot = part[i] + part[64 + i] + part[128 + i] + part[192 + i];
              const float rs = __builtin_amdgcn_rsqf(tot * (1.0f / 128.0f) + LN_EPS); const float rg = bf2f(crg[r]);
              CAT[(size_t)(row0 + i) * DM + h * 128 + c] = f2bf(acc[r] * rs * gn * (rg * __builtin_amdgcn_rcpf(1.0f + __expf(-rg)))); } }
    }
    LBAR();
#undef C3_LOAD_A
#undef C3_LOAD_B
}

__device__ __forceinline__ void phase_mla(const KArgs& a, char* lds) {
    unsigned char* wsq = optr(a.ws);
    const bf16_t* P = (const bf16_t*)(wsq + OFF_R); const bf16_t* QB = (const bf16_t*)(wsq + OFF_R + R_QB); const bf16_t* KVB = (const bf16_t*)(wsq + OFF_R + R_KVB);
    bf16_t* CAT = (bf16_t*)(wsq + OFF_HB);
    const float scale = 0.07216878364870322f;
    const int G_ = (int)gridDim.x, bi_ = obid(), nlat_ = (512 - bi_ + G_ - 1) / G_;
    for (int i = 0;; ++i) {
        int id;
        if (i < nlat_) id = i * G_ + bi_;
        else if (i == nlat_ && G_ >= 16 && bi_ >= G_ - 16) id = 512 + (bi_ - (G_ - 16));
        else if (G_ < 16 && 512 + (i - nlat_) * G_ + bi_ < 528) id = 512 + (i - nlat_) * G_ + bi_;
        else break;
        fa::Args A; int b, h;
        if (id < 512) { const int c = id & 255, rnd = id >> 8; const int bh = (c & 7) + 8 * rnd, qb = c >> 3; b = bh >> 2; h = bh & 3;
            const int qrow = b * SEQ + qb * 256; A.Q = QB + (size_t)qrow * 768 + h * 192; A.O = CAT + (size_t)qrow * DM + 512 + h * 128; A.NT = NCH; A.rope = (const f32x2*)(wsq + OFF_ROPE); A.pos0 = qb * 256; }
        else { const int c = id - 512; b = c >> 2; h = c & 3; const int qrow = ML + b * CTXL; A.Q = QB + (size_t)qrow * 768 + h * 192; A.O = CAT + (size_t)qrow * DM + 512 + h * 128; A.NT = 4; A.rope = nullptr; A.pos0 = 0; }
        A.ldq = 768; A.ldo = DM; A.K1 = KVB + h * 256; A.ldk1 = 1024; A.K2 = P + PC_KR; A.ldk2 = PW; A.V = KVB + h * 256 + 128; A.ldv = 1024;
        A.ctxrow0 = ML + b * CTXL; A.latrow0 = b * SEQ; A.C = scale * 1.4426950408889634f; A.thr = 8.0f / scale; A.rpb = nullptr; A.masked = 0; A.r0 = 0; A.krow0 = 0;
#ifndef NO_MLA
        fa::flash_unit<192, 128, false>(lds, A);
#endif
    }
}
__device__ __forceinline__ void phase_na(const KArgs& a, int io, char* lds) {
    unsigned char* wsq = optr(a.ws);
    const bf16_t* QKV = (const bf16_t*)(wsq + OFF_R); bf16_t* CAT = (bf16_t*)(wsq + OFF_HB);
    for (int i = 0;; ++i) {
        const int id = i * gridDim.x + obid(); if (id >= 2048 + 64) break;
        fa::Args A; int b, h;
        if (id < 2048) { const int rb = ((id & 7) << 2) | ((id >> 3) & 3);     h = (id >> 5) & 15; b = id >> 9; const int qrow = b * SEQ + rb * 256; const int r0 = rb * 4, krow0 = min(max(r0 - 4, 0), 116);
            A.Q = QKV + (size_t)qrow * 3072 + h * 64; A.O = CAT + (size_t)qrow * DM + h * 64; A.NT = 16; A.masked = 1; A.r0 = r0; A.krow0 = krow0; A.latrow0 = b * SEQ + krow0 * 64;
            A.rpb = (const float*)(wsq + OFF_PAR) + PQ_RPB + (size_t)(io * 16 + h) * 465; }
        else { const int c = id - 2048; b = c >> 4; h = c & 15; const int qrow = ML + b * CTXL;
            A.Q = QKV + (size_t)qrow * 3072 + h * 64; A.O = CAT + (size_t)qrow * DM + h * 64; A.NT = 4; A.masked = 0; A.r0 = 0; A.krow0 = 0; A.latrow0 = 0; A.rpb = nullptr; }
        A.ldq = 3072; A.ldo = DM; A.K1 = QKV + 1024 + h * 64; A.ldk1 = 3072; A.K2 = nullptr; A.ldk2 = 0; A.V = QKV + 2048 + h * 64; A.ldv = 3072;
        A.ctxrow0 = ML + b * CTXL; A.C = 0.125f * 1.4426950408889634f; A.thr = 64.0f; A.rope = nullptr; A.pos0 = 0;
#ifndef NO_NA
        fa::flash_unit<64, 64, true>(lds, A);
#endif
    }
}

#define XB_TMO      128
#define XB_XCNT(j)  (256  + 64 * (j))
#define XB_XSUB(j)  (1280 + 64 * (j))
#define XB_XGEN(j)  (2304 + 64 * (j))
#define XB_TOP      3328
#define XB_TOPGEN   3392
#define XCD_BAR_WORDS 3456
#define XB_SPIN_CAP (1u << 18)
__device__ __forceinline__ unsigned xb_ld(unsigned* p)              { return __hip_atomic_load(p, __ATOMIC_RELAXED, __HIP_MEMORY_SCOPE_AGENT); }
__device__ __forceinline__ unsigned xb_add(unsigned* p, unsigned v) { return __hip_atomic_fetch_add(p, v, __ATOMIC_RELAXED, __HIP_MEMORY_SCOPE_AGENT); }
__device__ __forceinline__ unsigned xb_xcc_id() { return (unsigned)__builtin_amdgcn_s_getreg((3 << 11) | 20) & 0xFu; }
#define XB_SPIN(cond, bar) do { unsigned _sp = 0; while (cond) { __builtin_amdgcn_s_sleep(1); \
    if ((++_sp & 255u) == 0u) { if (xb_ld(&(bar)[XB_TMO])) break; if (_sp > XB_SPIN_CAP) { atomicAdd(&(bar)[XB_TMO], 1u); break; } } } } while (0)
__device__ __forceinline__ void xcd_barrier_complete(unsigned* bar, unsigned x, unsigned& nloc, unsigned& nx) {
    const unsigned G = gridDim.x * gridDim.y * gridDim.z;
    unsigned sum, cnt, mine, sp = 0u;
    for (;;) {
        sum = 0u; cnt = 0u; mine = 0u;
#pragma unroll
        for (unsigned j = 0; j < 16; ++j) { const unsigned c = xb_ld(&bar[XB_XCNT(j)]); sum += c; cnt += (c > 0u) ? 1u : 0u; mine = (j == x) ? c : mine; }
        if (sum == G) break;
        __builtin_amdgcn_s_sleep(1);
        if ((++sp & 255u) == 0u) { if (xb_ld(&bar[XB_TMO])) break; if (sp > XB_SPIN_CAP) { atomicAdd(&bar[XB_TMO], 1u); break; } }
    }
    nloc = mine > 0u ? mine : 1u; nx = cnt > 0u ? cnt : 1u;
}
__device__ __forceinline__ void xcd_barrier(unsigned* bar, volatile LAS unsigned* st) {
    asm volatile("s_waitcnt vmcnt(0)" ::: "memory");
    __syncthreads();
    if (threadIdx.x == 0) {
        __builtin_amdgcn_s_waitcnt(0);
        const unsigned x = xb_xcc_id();
        unsigned nloc = st[0], nx = st[1];
        if (nloc == 0u) { xcd_barrier_complete(bar, x, nloc, nx); st[0] = nloc; st[1] = nx; }
        const unsigned old = xb_add(&bar[XB_XSUB(x)], 1u);
        const unsigned gen = old / nloc;
        if (old + 1u == (gen + 1u) * nloc) {
            __builtin_amdgcn_fence(__ATOMIC_RELEASE, "agent");
            asm volatile("s_waitcnt vmcnt(0)" ::: "memory");
            const unsigned og = xb_add(&bar[XB_TOP], 1u);
            const unsigned tg = og / nx;
            if (og + 1u == (tg + 1u) * nx) xb_add(&bar[XB_TOPGEN], 1u);
            else XB_SPIN(xb_ld(&bar[XB_TOPGEN]) == tg, bar);
            __builtin_amdgcn_fence(__ATOMIC_ACQUIRE, "agent");
            xb_add(&bar[XB_XGEN(x)], 1u);
            asm volatile("s_waitcnt vmcnt(0)" ::: "memory");
        } else {
            XB_SPIN(xb_ld(&bar[XB_XGEN(x)]) == gen, bar);
            __builtin_amdgcn_fence(__ATOMIC_ACQUIRE, "agent");
            asm volatile("s_waitcnt vmcnt(0)" ::: "memory");
        }
    }
    __syncthreads();
}

constexpr int LDS_BYTES = 147456;
constexpr int NPH = 2 + 4 * 12;

__global__ void __launch_bounds__(512, 2) mega(KArgs a) {
    extern __shared__ __attribute__((aligned(16))) unsigned char lds[];
    cg::grid_group grid = cg::this_grid();
    volatile LAS unsigned* bst = (volatile LAS unsigned*)((LAS unsigned char*)lds + 131072 + 64);
    unsigned* bar = (unsigned*)(a.ws + OFF_BAR);
    if (threadIdx.x == 0) { bst[0] = 0u; bst[1] = 0u; (void)xb_add(&bar[XB_XCNT(xb_xcc_id())], 1u); }
    __syncthreads();
    bool first = true;
    if (a.lo == 0) {
        for (int rep = 0; rep < 1 + ((DUP >> 5) & 1); ++rep) { phase_prep(a, lds); __syncthreads(); }
        if (a.hi < 0) grid.sync();
        xcd_barrier((unsigned*)(optr(a.ws) + OFF_BAR), bst);
        phase_init_h(a);
        first = false;
    }
    for (int ph = (a.lo < 2 ? 2 : a.lo); ph < a.hi; ++ph) {
        int l = 0, st = -1;
        if (ph >= 2) { l = (ph - 2) / 12; st = (ph - 2) % 12; }
        const bool odd = (l & 1) != 0; const int ie = l >> 1;
        if (ph >= 2 && odd && (st == 5 || st == 6)) continue;
        if (!first) { xcd_barrier((unsigned*)(optr(a.ws) + OFF_BAR), bst); if ((DUP >> 6) & 1) xcd_barrier((unsigned*)(optr(a.ws) + OFF_BAR), bst); }
        first = false;
        unsigned char* ws = optr(a.ws);
        float* mod = (float*)(ws + OFF_MOD); bf16_t* Hb = (bf16_t*)(ws + OFF_HB); float* Xc = (float*)(ws + OFF_XC);
        unsigned char* wl = ws + OFF_W + (size_t)l * WL_BYTES; unsigned char* we = ws + OFF_WE + (size_t)ie * 8 * MiB; unsigned char* wo = ws + OFF_WO + (size_t)ie * 8 * MiB;
        const float* modl = mod + (size_t)l * 5 * 9216;
        if (st == 0 || st == 9) {
            pg8::Gemm g{Hb, (const bf16_t*)(wl + (st == 0 ? 0 : W2IN_O)), MR, 2 * DFF, DM, DM, DM};
            pg8::StaticOrder S; S.init((l == 3 && st == 9) ? ML : MR, 2 * DFF, DM, gridDim.x, obid(), 0);
            pg8::EpiSwiglu E{(bf16_t*)(ws + OFF_R), DFF};
            for (int rep = 0; rep < 1 + ((DUP >> 3) & 1); ++rep) pg8::gemm_phase<pg8::EpiSwiglu>((LAS unsigned char*)lds, g, S, E);
            if (st == 0 && l < 3) {
                const int bi = obid(), nfree = (int)gridDim.x - 88;
                if (nfree > 0 && bi >= 88) { const int otw = otid(); convert_layer(a, l + 1, (bi - 88) * 8 + (otw >> 6), nfree * 8, (LAS float*)((LAS unsigned char*)lds + (otw >> 6) * 16384), otw & 63); }
                else if (nfree <= 0) { const int otw = otid(); convert_layer(a, l + 1, bi * 8 + (otw >> 6), (int)gridDim.x * 8, (LAS float*)((LAS unsigned char*)lds + (otw >> 6) * 16384), otw & 63); }
            }
        }
        else if (st == 1 || st == 3 || st == 5 || st == 7 || st == 10) {
            const int nsub = (st == 5) ? 2 : 1;
            for (int sub = 0; sub < nsub; ++sub) {
                pg8::Gemm g; pg8::EpiStore E; bf16_t* PARTB = (bf16_t*)(ws + OFF_R + R_PART);
                if (st == 1 || st == 10) { g = pg8::Gemm{(const bf16_t*)(ws + OFF_R), (const bf16_t*)(wl + (st == 1 ? W1OUT_O : W2OUT_O)), MR, DM, DFF, DFF, DFF}; E = pg8::EpiStore{Hb, DM, DM, PARTB}; }
                else if (st == 3) {
                    if (!odd) { g = pg8::Gemm{Hb, (const bf16_t*)we, MR, 2304, DM, DM, DM}; E = pg8::EpiStore{(bf16_t*)(ws + OFF_R), PW, PW, nullptr}; }
                    else { g = pg8::Gemm{Hb, (const bf16_t*)wo, MR, 3072, DM, DM, DM}; E = pg8::EpiStore{(bf16_t*)(ws + OFF_R), 3072, 3072, nullptr}; }
                }
                else if (st == 5) {
                    if (sub == 0) { g = pg8::Gemm{(const bf16_t*)(ws + OFF_R) + PC_CQ, (const bf16_t*)(we + WUQ_O), MR, 768, 384, PW, 384}; E = pg8::EpiStore{(bf16_t*)(ws + OFF_R + R_QB), 768, 768, nullptr}; }
                    else { g = pg8::Gemm{(const bf16_t*)(ws + OFF_R) + PC_CKV, (const bf16_t*)(we + WUKV_O), MR, 1024, 128, PW, 128}; E = pg8::EpiStore{(bf16_t*)(ws + OFF_R + R_KVB), 1024, 1024, nullptr}; }
                }
                else { g = pg8::Gemm{Hb, (const bf16_t*)(odd ? wo + WNO_O : we + WEO_O), MR, DM, DM, DM, DM}; E = pg8::EpiStore{(bf16_t*)(ws + OFF_R + (odd ? R_YODD : 0)), DM, DM, PARTB}; }
                pg8::StaticOrder S; S.init(g.M, g.N, g.K, gridDim.x, obid(), (st == 1 || st == 10 || st == 7) ? 1 : 0); if (l == 3 && st == 10) S.nextra = 0;
                for (int rep = 0; rep < 1 + (((DUP >> 4) & 1) & (st == 1 || st == 10)); ++rep) pg8::gemm_phase<pg8::EpiStore>((LAS unsigned char*)lds, g, S, E);
            }
#ifndef NO_C2
            if (st == 5) phase_gla_c2(a);
#endif
        }
        else if (st == 2 || st == 8 || st == 11) {
            const float* xl_src = (l == 0 && st == 2) ? a.in[I_X] : a.out; const float* xc_src = (l == 0 && st == 2) ? a.in[I_CTX] : Xc;
            const bf16_t* Y = (st == 8) ? (const bf16_t*)(ws + OFF_R + (odd ? R_YODD : 0)) : Hb;
            const float* modg = modl + (st == 2 ? 2 : st == 8 ? 5 : 8) * 1024; const float coef = (st == 8) ? 1.0f : 0.5f;
            const float* modh = (st == 2) ? modl + 3 * 1024 : (st == 8) ? modl + 6 * 1024 : (l < 3 ? modl + 5 * 9216 : nullptr);
            if (((DUP >> 7) & 1) && st != 8) phase_ln(xl_src, xc_src, (float*)(ws + OFF_R), (float*)(ws + OFF_R + 128 * MiB), Y, DM, modg, coef, modh, (bf16_t*)(ws + OFF_R + 140 * MiB), (const bf16_t*)(ws + OFF_R + R_PART), (st == 8) ? 4 : 11);
            phase_ln(xl_src, xc_src, a.out, Xc, Y, DM, modg, coef, modh, Hb, (const bf16_t*)(ws + OFF_R + R_PART), (st == 8) ? 4 : 11);
        }
        else if (st == 4) {
            if (!odd) { phase_evenD((bf16_t*)(ws + OFF_R), (const float*)(ws + OFF_PAR) + PQ_QNG + ie * 384, (const float*)(ws + OFF_PAR) + PQ_KVNG + ie * 128, (const f32x2*)(ws + OFF_ROPE));
 for (int rep = 0; rep < 1 + ((DUP >> 2) & 1); ++rep) phase_gla_c1(a, ie, (char*)lds);
 }
            else for (int rep = 0; rep < 1 + ((DUP >> 1) & 1); ++rep) phase_na(a, ie, (char*)lds);
        }
        else if (st == 6) { for (int rep = 0; rep < 1 + ((DUP >> 0) & 1); ++rep) phase_mla(a, (char*)lds);
 for (int rep = 0; rep < 1 + ((DUP >> 2) & 1); ++rep) phase_gla_c3(a, ie, (char*)lds);
 }
    }
}

extern "C" void kernel_launch(void* const* d_in, const int* in_sizes, int n_in, void* d_out, int out_size, void* d_ws, size_t ws_size, hipStream_t stream) {
    static int grid = 0;
    if (grid == 0) {
        if (n_in != 24 || in_sizes[0] != ML * DM || out_size != ML * DM || ws_size < WS_END) {
            fprintf(stderr, "kernel_launch: unexpected shapes (n_in %d, in0 %d, out %d, ws %zu need %zu); nothing launched\n", n_in, n_in > 0 ? in_sizes[0] : -1, out_size, ws_size, (size_t)WS_END); grid = -1; return; }
        int dev = 0, cus = 0, per_cu = 0;
        hipGetDevice(&dev); hipDeviceGetAttribute(&cus, hipDeviceAttributeMultiprocessorCount, dev);
        if (hipFuncSetAttribute((const void*)mega, hipFuncAttributeMaxDynamicSharedMemorySize, LDS_BYTES) != hipSuccess) { fprintf(stderr, "kernel_launch: hipFuncSetAttribute failed\n"); grid = -1; return; }
        if (hipOccupancyMaxActiveBlocksPerMultiprocessor(&per_cu, (const void*)mega, 512, LDS_BYTES) != hipSuccess || per_cu < 1) { fprintf(stderr, "kernel_launch: occupancy query says %d blocks per CU\n", per_cu); per_cu = 1; }
        (void)hipGetLastError();
        grid = cus * per_cu;
    }
    if (grid < 0) return;
    KArgs a{};
    for (int i = 0; i < 24; ++i) a.in[i] = (const float*)d_in[i];
    a.out = (float*)d_out; a.ws = (unsigned char*)d_ws; a.lo = 0; a.hi = DBG_HI;
    (void)hipMemsetAsync((char*)d_ws + OFF_BAR, 0, 16384, stream);
    void* args[] = {&a};
    hipError_t e = hipLaunchCooperativeKernel((const void*)mega, dim3(grid), dim3(512), args, LDS_BYTES, stream);
    if (e != hipSuccess) fprintf(stderr, "kernel_launch: cooperative launch failed: %s (grid %d)\n", hipGetErrorString(e), grid);
}
```

```cpp
#include <hip/hip_runtime.h>
#include <hip/hip_cooperative_groups.h>
#include <cstdio>
#include <cstdint>
namespace cg = cooperative_groups;
#ifndef DBG_HI
#define DBG_HI NPH
#endif
#ifndef DUP
#define DUP 0
#endif

#define LAS __attribute__((address_space(3)))
typedef unsigned short bf16_t;
typedef short bf16x8 __attribute__((ext_vector_type(8)));
typedef short s16x4 __attribute__((ext_vector_type(4)));
typedef float f32x4 __attribute__((ext_vector_type(4)));
typedef float f32x2 __attribute__((ext_vector_type(2)));
typedef float f32x16 __attribute__((ext_vector_type(16)));
typedef unsigned u32x4 __attribute__((ext_vector_type(4)));
typedef unsigned u32x2 __attribute__((ext_vector_type(2)));

constexpr int DM = 1024, NB = 4, SEQ = 8192, CTXL = 256, ML = NB * SEQ, MC = NB * CTXL, MR = ML + MC;
constexpr int DFF = 2816, PW = 2144, NCH = 132;
constexpr float LN_EPS = 1e-6f;
constexpr float ALPHA = 1.6817928305074290f;
constexpr int PC_Q = 0, PC_K = 256, PC_V = 512, PC_R = 1024, PC_LRF = 1536, PC_CQ = 1568, PC_CKV = 1952, PC_KR = 2080;

constexpr size_t MiB = 1u << 20;
constexpr size_t OFF_MOD = 0;
constexpr size_t OFF_PAR = 768 * 1024;
constexpr int PQ_QNG = 0, PQ_KVNG = 768, PQ_WG2F = 1024, PQ_BGF = 9216, PQ_WG2B = 9728, PQ_BGB = 17920, PQ_GLANG = 18432, PQ_RPB = 18688;
constexpr size_t OFF_BAR = 960 * 1024;
constexpr size_t OFF_ROPE = 1 * MiB;
constexpr size_t OFF_XC = 3 * MiB;
constexpr size_t OFF_W = 7 * MiB;
constexpr size_t WL_BYTES = 33 * MiB, W1OUT_O = 11 * MiB, W2IN_O = 16 * MiB + MiB / 2, W2OUT_O = 27 * MiB + MiB / 2;
constexpr size_t OFF_WE = OFF_W + 4 * WL_BYTES;
constexpr size_t WUQ_O = 4 * MiB + MiB / 2, WUKV_O = 5 * MiB + MiB / 4, WEO_O = 5 * MiB + MiB / 2;
constexpr size_t OFF_WO = OFF_WE + 16 * MiB;
constexpr size_t WNO_O = 6 * MiB;
constexpr size_t OFF_HB = OFF_WO + 16 * MiB;
constexpr size_t OFF_R = OFF_HB + 66 * MiB;
constexpr size_t R_SL = 139 * MiB, R_DEC = 205 * MiB, R_QB = 207 * MiB, R_KVB = 257 * MiB, R_END = 323 * MiB;
constexpr size_t R_YODD = 198 * MiB;
constexpr size_t R_PART = 270 * MiB;
constexpr size_t WS_END = OFF_R + R_END;

__device__ __forceinline__ int otid() { int t = threadIdx.x; asm volatile("" : "+v"(t)); return t; }
__device__ __forceinline__ int obid() { int b = blockIdx.x; asm volatile("" : "+s"(b)); return b; }
__device__ __forceinline__ unsigned char* optr(unsigned char* p) { size_t z = 0; asm volatile("" : "+s"(z)); return p + z; }

namespace pg8 {
constexpr int BM = 256, BK = 64, HALF = 128, HTB = HALF * BK * 2, STAGE_BYTES = 8 * HTB, NXCD = 8, WGM = 8;
__host__ __device__ __forceinline__ int lds_byte(int r, int c) { const int st = (r >> 4) * 2 + (c >> 5), rr = r & 15, cc = c & 31, ob = rr * 64 + cc * 2; return st * 1024 + (ob ^ (((ob >> 9) & 1) << 5)); }
__host__ __device__ __forceinline__ void stage_rc(int b, int& R, int& C) { const int st = b / 1024, sb = b % 1024, swz = sb ^ (((sb >> 9) & 1) << 5); R = (st >> 1) * 16 + swz / 64; C = (st & 1) * 32 + (swz % 64) / 2; }
__host__ __device__ __forceinline__ int perm32(int rho) { const int n = rho >> 4, i = rho & 15; return 8 * (i >> 2) + 4 * n + (i & 3); }
struct Unit { int pm, pn, kt0, nt, part; };
struct Gemm { const bf16_t* A; const bf16_t* Bt; int M, N, K, lda, ldb; };
struct StaticOrder {
    int nM, nN, nwg, G, c, ntk, nsplit, nextra;
    __device__ void init(int M, int N, int K, int G_, int c_, int split) { nN = N / BM; ntk = K / BK; nM = split ? 128 : M / BM; nsplit = split ? ntk / 4 : 0; nextra = 4 * nN * nsplit; nwg = nM * nN; G = G_; c = c_; }
    __device__ bool next(int i, Unit& u) const {
        long L = (long)i * G + c;
        if (L >= nwg) { L -= nwg; if (L >= nextra) return false; const int part = (int)L % nsplit, tile = (int)L / nsplit; u.pn = tile % nN; u.pm = 128 + tile / nN; u.kt0 = part * 4; u.nt = 4; u.part = part; return true; }
        int wgid = (int)L; { const int q = nwg / NXCD, r = nwg % NXCD, xcd = wgid % NXCD, off = wgid / NXCD; wgid = (xcd < r ? xcd * (q + 1) : r * (q + 1) + (xcd - r) * q) + off; }
        const int nig = WGM * nN, gid = wgid / nig, fm = gid * WGM, gsz = (nM - fm) < WGM ? (nM - fm) : WGM;
        u.pm = fm + ((wgid % nig) % gsz); u.pn = (wgid % nig) / gsz; u.kt0 = 0; u.nt = ntk; u.part = -1; return true;
    }
};
typedef __bf16 bf16x2_t __attribute__((ext_vector_type(2)));
__device__ __forceinline__ unsigned cvt_pk_bf16(float lo, float hi) { f32x2 v = {lo, hi}; bf16x2_t b = __builtin_convertvector(v, bf16x2_t); return __builtin_bit_cast(unsigned, b); }

struct EpiStore {
    static constexpr bool PERM = true;
    bf16_t* O; int ldc; int ncols; bf16_t* PART;
    __device__ __forceinline__ void operator()(const f32x4 (&acc)[2][2][4][2], const Unit& u, int wr, int wc, int fr, int fq) const {
        int row0 = u.pm * BM + wr * 64 + fr; const int col0 = u.pn * BM + wc * 32 + 8 * fq; bf16_t* Ob = O;
        if (u.part >= 0) { Ob = PART + (size_t)u.part * 1024 * 1024; row0 -= 128 * BM; }
#pragma unroll
        for (int ai = 0; ai < 2; ++ai)
#pragma unroll
            for (int m = 0; m < 4; ++m) { bf16_t* rowp = Ob + (size_t)(row0 + ai * HALF + m * 16) * ldc + col0;
#pragma unroll
                for (int bj = 0; bj < 2; ++bj) { const f32x4 v0 = acc[ai][bj][m][0], v1 = acc[ai][bj][m][1];
                    u32x4 w; w.x = cvt_pk_bf16(v0[0], v0[1]); w.y = cvt_pk_bf16(v0[2], v0[3]); w.z = cvt_pk_bf16(v1[0], v1[1]); w.w = cvt_pk_bf16(v1[2], v1[3]);
                    if (col0 + bj * HALF < ncols) *(u32x4*)(rowp + bj * HALF) = w; } }
    }
};
__device__ __forceinline__ float silu_f(float x) { return x * __builtin_amdgcn_rcpf(1.0f + __builtin_amdgcn_exp2f(-1.4426950408889634f * x)); }
struct EpiSwiglu {
    static constexpr bool PERM = true;
    bf16_t* O; int ldc;
    __device__ __forceinline__ void operator()(const f32x4 (&acc)[2][2][4][2], const Unit& u, int wr, int wc, int fr, int fq) const {
        const int row0 = u.pm * BM + wr * 64 + fr; const int col0 = u.pn * HALF + wc * 32 + 8 * fq;
#pragma unroll
        for (int ai = 0; ai < 2; ++ai)
#pragma unroll
            for (int m = 0; m < 4; ++m) { bf16_t* rowp = O + (size_t)(row0 + ai * HALF + m * 16) * ldc + col0;
                const f32x4 g0 = acc[ai][0][m][0], g1 = acc[ai][0][m][1], u0 = acc[ai][1][m][0], u1 = acc[ai][1][m][1];
                u32x4 w; w.x = cvt_pk_bf16(silu_f(g0[0]) * u0[0], silu_f(g0[1]) * u0[1]); w.y = cvt_pk_bf16(silu_f(g0[2]) * u0[2], silu_f(g0[3]) * u0[3]);
                w.z = cvt_pk_bf16(silu_f(g1[0]) * u1[0], silu_f(g1[1]) * u1[1]); w.w = cvt_pk_bf16(silu_f(g1[2]) * u1[2], silu_f(g1[3]) * u1[3]);
                *(u32x4*)rowp = w; }
    }
};

template <class Epi>
__device__ __forceinline__ void gemm_phase(LAS unsigned char* lds, const Gemm g, const StaticOrder& S, const Epi& E) {
    const int tid = otid(), wid = __builtin_amdgcn_readfirstlane(tid >> 6), lane = tid & 63, wr = wid >> 2, wc = wid & 3, fr = lane & 15, fq = lane >> 4;
    unsigned voffA[2], voffB[2];
#pragma unroll
    for (int i = 0; i < 2; ++i) { int R, C; stage_rc(tid * 16 + i * 8192, R, C); const int Rb = Epi::PERM ? ((R & ~31) + perm32(R & 31)) : R;
        voffA[i] = (unsigned)(R * g.lda + C) * 2u; voffB[i] = (unsigned)(Rb * g.ldb + C) * 2u; }
    const size_t kstep = (size_t)(BK * 2);
    const size_t hsA = (size_t)HALF * g.lda * 2, hsB = (size_t)HALF * g.ldb * 2;
    const size_t tsA = 2 * hsA, tsB = 2 * hsB;
    const unsigned ldsw = (unsigned)wid * 1024u;
    const int aoff = lds_byte(wr * 64 + fr, fq * 8), boff = lds_byte(wc * 32 + fr, fq * 8);
#define PG8_SA(b, h) (((b) * 2 + (h)) * HTB)
#define PG8_SB(b, h) ((4 + (b) * 2 + (h)) * HTB)
#define PG8_STAGE(bufoff, gbase, voff) do { _Pragma("unroll") for (int _i = 0; _i < 2; ++_i) \
        __builtin_amdgcn_global_load_lds((const unsigned*)((const char*)(gbase) + (voff)[_i]), (LAS unsigned*)(lds + (bufoff) + ldsw + _i * 8192), 16, 0, 0); } while (0)
#define PG8_LDA(dst, b, h) do { _Pragma("unroll") for (int m = 0; m < 4; ++m) _Pragma("unroll") for (int k = 0; k < 2; ++k) dst[m][k] = *(const LAS bf16x8*)(lds + PG8_SA(b, h) + aoff + m * 2048 + k * 1024); } while (0)
#define PG8_LDB(dst, b, h) do { _Pragma("unroll") for (int n = 0; n < 2; ++n) _Pragma("unroll") for (int k = 0; k < 2; ++k) dst[n][k] = *(const LAS bf16x8*)(lds + PG8_SB(b, h) + boff + n * 2048 + k * 1024); } while (0)
#define PG8_MMA(ai, bj, At, Bt) do { __builtin_amdgcn_s_setprio(1); _Pragma("unroll") for (int m = 0; m < 4; ++m) _Pragma("unroll") for (int n = 0; n < 2; ++n) _Pragma("unroll") for (int k = 0; k < 2; ++k) \
        acc[ai][bj][m][n] = __builtin_amdgcn_mfma_f32_16x16x32_bf16(Bt[n][k], At[m][k], acc[ai][bj][m][n], 0, 0, 0); __builtin_amdgcn_s_setprio(0); } while (0)
#define PG8_WAIT_V(n) asm volatile("s_waitcnt vmcnt(" #n ")" ::: "memory")
#define PG8_WAIT_L(n) asm volatile("s_waitcnt lgkmcnt(" #n ")" ::: "memory")
#define PG8_BAR __builtin_amdgcn_s_barrier()
#define PG8_SCHED __builtin_amdgcn_sched_barrier(0)
    Unit cur, nxt; int ui = 0;
    if (!S.next(0, cur)) return;
    f32x4 acc[2][2][4][2];
#pragma unroll
    for (int a = 0; a < 2; ++a)
#pragma unroll
        for (int b = 0; b < 2; ++b)
#pragma unroll
            for (int m = 0; m < 4; ++m)
#pragma unroll
                for (int n = 0; n < 2; ++n) acc[a][b][m][n] = (f32x4){0.f, 0.f, 0.f, 0.f};
    bf16x8 At[4][2], B0[2][2], B1[2][2];
    const char* cA = (const char*)g.A + (size_t)cur.pm * tsA + (size_t)cur.kt0 * kstep; const char* cB = (const char*)g.Bt + (size_t)cur.pn * tsB + (size_t)cur.kt0 * kstep;
    PG8_STAGE(PG8_SB(0, 0), cB, voffB); PG8_STAGE(PG8_SB(0, 1), cB + hsB, voffB); PG8_STAGE(PG8_SA(0, 0), cA, voffA); PG8_STAGE(PG8_SA(0, 1), cA + hsA, voffA);
    if (wr == 1) PG8_BAR;
    PG8_WAIT_V(2); PG8_BAR;
    PG8_STAGE(PG8_SB(1, 0), cB + kstep, voffB); PG8_STAGE(PG8_SA(1, 0), cA + kstep, voffA); PG8_STAGE(PG8_SB(1, 1), cB + hsB + kstep, voffB);
    PG8_WAIT_V(6); PG8_BAR;
    for (;;) {
        const bool has_next = S.next(ui + 1, nxt);
        const char* nA = has_next ? (const char*)g.A + (size_t)nxt.pm * tsA + (size_t)nxt.kt0 * kstep : cA; const char* nB = has_next ? (const char*)g.Bt + (size_t)nxt.pn * tsB + (size_t)nxt.kt0 * kstep : cB;
        const int nt = cur.nt;
        for (int t = 0; t < nt; t += 2) {
            const bool last = (t == nt - 2);
            const char* a1 = cA + (size_t)(t + 1) * kstep;
            const char* a2 = last ? nA : cA + (size_t)(t + 2) * kstep; const char* b2 = last ? nB : cB + (size_t)(t + 2) * kstep;
            const char* a3 = a2 + kstep; const char* b3 = b2 + kstep;
            PG8_LDB(B0, 0, 0); PG8_LDB(B1, 0, 1); PG8_SCHED; PG8_LDA(At, 0, 0); PG8_STAGE(PG8_SA(1, 1), a1 + hsA, voffA);
            PG8_WAIT_V(8); PG8_WAIT_L(0); PG8_BAR; PG8_MMA(0, 0, At, B0); PG8_MMA(0, 1, At, B1); PG8_BAR; PG8_SCHED;
            PG8_LDA(At, 0, 1); PG8_STAGE(PG8_SB(0, 0), b2, voffB); PG8_STAGE(PG8_SB(0, 1), b2 + hsB, voffB); PG8_STAGE(PG8_SA(0, 0), a2, voffA);
            PG8_WAIT_V(8); PG8_WAIT_L(0); PG8_BAR; PG8_MMA(1, 0, At, B0); PG8_MMA(1, 1, At, B1); PG8_BAR; PG8_SCHED;
            PG8_LDB(B0, 1, 0); PG8_LDB(B1, 1, 1); PG8_SCHED; PG8_LDA(At, 1, 0); PG8_STAGE(PG8_SA(0, 1), a2 + hsA, voffA);
            PG8_WAIT_V(8); PG8_WAIT_L(0); PG8_BAR; PG8_MMA(0, 0, At, B0); PG8_MMA(0, 1, At, B1); PG8_BAR; PG8_SCHED;
            PG8_LDA(At, 1, 1); PG8_STAGE(PG8_SB(1, 0), b3, voffB); PG8_STAGE(PG8_SB(1, 1), b3 + hsB, voffB); PG8_STAGE(PG8_SA(1, 0), a3, voffA);
            PG8_WAIT_V(8); PG8_WAIT_L(0); PG8_BAR; PG8_MMA(1, 0, At, B0); PG8_MMA(1, 1, At, B1); PG8_BAR; PG8_SCHED;
        }
        if (wr == 0) PG8_BAR;
        E(acc, cur, wr, wc, fr, fq);
        if (!has_next) break;
#pragma unroll
        for (int a = 0; a < 2; ++a)
#pragma unroll
            for (int b = 0; b < 2; ++b)
#pragma unroll
                for (int m = 0; m < 4; ++m)
#pragma unroll
                    for (int n = 0; n < 2; ++n) acc[a][b][m][n] = (f32x4){0.f, 0.f, 0.f, 0.f};
        cur = nxt; cA = nA; cB = nB; ++ui;
        if (wr == 1) PG8_BAR;
    }
    PG8_WAIT_V(0);
    PG8_BAR;
#undef PG8_SA
#undef PG8_SB
#undef PG8_STAGE
#undef PG8_LDA
#undef PG8_LDB
#undef PG8_MMA
#undef PG8_WAIT_V
#undef PG8_WAIT_L
#undef PG8_BAR
#undef PG8_SCHED
}
}

__device__ __forceinline__ float bf2f(unsigned short h) { return __uint_as_float((unsigned)h << 16); }
__device__ __forceinline__ unsigned pk2(float lo, float hi) { return pg8::cvt_pk_bf16(lo, hi); }
__device__ __forceinline__ bf16_t f2bf(float f) { return (bf16_t)(pk2(f, 0.f) & 0xffffu); }
__device__ __forceinline__ float wave_sum(float v) {
#pragma unroll
    for (int o = 1; o < 64; o <<= 1) v += __shfl_xor(v, o);
    return v;
}
__device__ __forceinline__ int crow(int r, int hi) { return (r & 3) + 8 * (r >> 2) + 4 * hi; }
__device__ __forceinline__ float logsig16(float x) { return (fminf(x, 0.f) - __logf(1.0f + __expf(-fabsf(x)))) * 0.0625f; }

namespace fa {
#define SBAR() __builtin_amdgcn_sched_barrier(0)
#define KOFF(PITCH, row, colB) ((row) * (PITCH) + ((colB) ^ ((((row) >> 1) & 7) << 4)))
struct Args {
    const bf16_t* Q; int ldq;
    const bf16_t* K1; int ldk1; const bf16_t* K2; int ldk2; const bf16_t* V; int ldv;
    bf16_t* O; int ldo;
    int ctxrow0, latrow0, NT;
    float C, thr;
    const f32x2* rope; int pos0;
    const float* rpb; int masked; int r0, krow0;
};
__device__ __forceinline__ void partialSM(f32x16& p0, f32x16& p1, float& m_reg, float& mn, float& alpha, float C, float thr) {
    float pmax = p0[0];
#pragma unroll
    for (int r = 1; r < 16; ++r) pmax = fmaxf(pmax, p0[r]);
#pragma unroll
    for (int r = 0; r < 16; ++r) pmax = fmaxf(pmax, p1[r]);
    { auto rr = __builtin_amdgcn_permlane32_swap(__float_as_uint(pmax), __float_as_uint(pmax), false, false);
      pmax = fmaxf(__uint_as_float(rr[0]), __uint_as_float(rr[1])); }
    if (__builtin_expect(__all(pmax - m_reg <= thr), 1)) { mn = m_reg; alpha = 1.f; }
    else { mn = fmaxf(m_reg, pmax); alpha = __builtin_amdgcn_exp2f((m_reg - mn) * C); m_reg = mn; }
    const float mnC = -mn * C;
#pragma unroll
    for (int r = 0; r < 16; ++r) p0[r] = fmaf(p0[r], C, mnC);
#pragma unroll
    for (int r = 0; r < 16; ++r) p1[r] = fmaf(p1[r], C, mnC);
#pragma unroll
    for (int r = 0; r < 16; ++r) p0[r] = __builtin_amdgcn_exp2f(p0[r]);
}
__device__ __forceinline__ void finishSM(f32x16& p0, f32x16& p1, float alpha, float& l_reg, bf16x8& pa0, bf16x8& pa1, bf16x8& pa2, bf16x8& pa3) {
#pragma unroll
    for (int r = 0; r < 16; ++r) p1[r] = __builtin_amdgcn_exp2f(p1[r]);
    float ps = 0;
#pragma unroll
    for (int r = 0; r < 16; ++r) ps += p0[r];
#pragma unroll
    for (int r = 0; r < 16; ++r) ps += p1[r];
    { auto rr = __builtin_amdgcn_permlane32_swap(__float_as_uint(ps), __float_as_uint(ps), false, false);
      ps = __uint_as_float(rr[0]) + __uint_as_float(rr[1]); }
    l_reg = l_reg * alpha + ps;
#define PK4(P, BASE, OUT) do { unsigned a0 = pk2(P[BASE + 0], P[BASE + 1]), a1 = pk2(P[BASE + 2], P[BASE + 3]);   \
    unsigned b0 = pk2(P[BASE + 4], P[BASE + 5]), b1 = pk2(P[BASE + 6], P[BASE + 7]);                              \
    auto r0 = __builtin_amdgcn_permlane32_swap(a0, b0, false, false); auto r1 = __builtin_amdgcn_permlane32_swap(a1, b1, false, false); \
    u32x4 w = {r0[0], r1[0], r0[1], r1[1]}; OUT = *reinterpret_cast<bf16x8*>(&w); } while (0)
    PK4(p0, 0, pa0); PK4(p0, 8, pa1); PK4(p1, 0, pa2); PK4(p1, 8, pa3);
#undef PK4
}
template <int DQK> __device__ __forceinline__ void qkt(f32x16& p0, f32x16& p1, const char* Ks, const bf16x8* qr, int r32, int hi) {
    constexpr int NQ = DQK / 16, PF = 2;
    p0 = f32x16{}; p1 = f32x16{};
    bf16x8 kb0[NQ], kb1[NQ];
#define KRD(d) do { const int cb_ = ((d) * 16 + hi * 8) * 2; kb0[d] = *reinterpret_cast<const bf16x8*>(Ks + KOFF(DQK * 2, r32, cb_)); kb1[d] = *reinterpret_cast<const bf16x8*>(Ks + KOFF(DQK * 2, 32 + r32, cb_)); } while (0)
#pragma unroll
    for (int d = 0; d < PF && d < NQ; ++d) KRD(d);
    SBAR();
#pragma unroll
    for (int d0 = 0; d0 < NQ; ++d0) {
        if (d0 + PF < NQ) KRD(d0 + PF);
        SBAR();
        p0 = __builtin_amdgcn_mfma_f32_32x32x16_bf16(kb0[d0], qr[d0], p0, 0, 0, 0);
        p1 = __builtin_amdgcn_mfma_f32_32x32x16_bf16(kb1[d0], qr[d0], p1, 0, 0, 0);
        SBAR();
    }
#undef KRD
}
template <int NCB> __device__ __forceinline__ int v_st(int k, int c) { const int kk = (k & ~0xC) | ((k & 4) << 1) | ((k & 8) >> 1); return ((kk >> 3) * NCB + (c >> 5)) * 512 + ((kk & 7) * 32 + (c & 31)) * 2; }
__device__ __forceinline__ int v_rd_base(int lane) { return ((lane & 3) << 3) | (((lane >> 2) & 3) << 6) | (((lane >> 4) & 1) << 5) | (((lane >> 5) & 1) << 8); }
template <int OFF> __device__ __forceinline__ s16x4 tr_read(int vb) {
    s16x4 r; asm volatile("ds_read_b64_tr_b16 %0, %1 offset:%2" : "=&v"(r) : "v"(vb), "i"(OFF) : "memory"); return r;
}
template <int D0, int NCB> __device__ __forceinline__ void pv_one(f32x16& od, int vb, bf16x8 pa0, bf16x8 pa1, bf16x8 pa2, bf16x8 pa3) {
    constexpr int KS = NCB * 1024, HF = NCB * 512, B = D0 * 512;
    const s16x4 l0 = tr_read<B>(vb), h0 = tr_read<B + HF>(vb), l1 = tr_read<B + KS>(vb), h1 = tr_read<B + KS + HF>(vb);
    const s16x4 l2 = tr_read<B + 2 * KS>(vb), h2 = tr_read<B + 2 * KS + HF>(vb), l3 = tr_read<B + 3 * KS>(vb), h3 = tr_read<B + 3 * KS + HF>(vb);
    asm volatile("s_waitcnt lgkmcnt(0)" ::: "memory"); SBAR();
#define PK(L, H) (bf16x8){L[0], L[1], L[2], L[3], H[0], H[1], H[2], H[3]}
    od = __builtin_amdgcn_mfma_f32_32x32x16_bf16(pa0, PK(l0, h0), od, 0, 0, 0);
    od = __builtin_amdgcn_mfma_f32_32x32x16_bf16(pa1, PK(l1, h1), od, 0, 0, 0);
    od = __builtin_amdgcn_mfma_f32_32x32x16_bf16(pa2, PK(l2, h2), od, 0, 0, 0);
    od = __builtin_amdgcn_mfma_f32_32x32x16_bf16(pa3, PK(l3, h3), od, 0, 0, 0);
#undef PK
}
template <int DV> __device__ __forceinline__ void pv_all(f32x16* o, int vb, bf16x8 pa0, bf16x8 pa1, bf16x8 pa2, bf16x8 pa3) {
    constexpr int NCB = DV / 32;
    pv_one<0, NCB>(o[0], vb, pa0, pa1, pa2, pa3); pv_one<1, NCB>(o[1], vb, pa0, pa1, pa2, pa3);
    if constexpr (DV == 128) { pv_one<2, NCB>(o[2], vb, pa0, pa1, pa2, pa3); pv_one<3, NCB>(o[3], vb, pa0, pa1, pa2, pa3); }
}
__device__ __forceinline__ void na_mask(f32x16& p0, f32x16& p1, const float* tr, bool rowvalid, int cs, int hi) {
    if (!rowvalid) {
#pragma unroll
        for (int r = 0; r < 16; ++r) { p0[r] = -1e30f; p1[r] = -1e30f; }
    } else {
#pragma unroll
        for (int r = 0; r < 16; ++r) { const int kc0 = (r & 3) + 8 * (r >> 2); const int kc = kc0 + 4 * hi;
            const bool v0 = (unsigned)(kc - cs) < 16u, v1 = (unsigned)(kc + 32 - cs) < 16u;
            const float b0 = tr[kc0], b1 = tr[kc0 + 32];
            p0[r] = v0 ? p0[r] + b0 : -1e30f; p1[r] = v1 ? p1[r] + b1 : -1e30f; }
    }
}

template <int DQK, int DV, bool NA>
__device__ __forceinline__ void flash_unit(char* lds, const Args& A) {
    constexpr int NQ = DQK / 16, NO = DV / 32, NCB = DV / 32, KP = DQK * 2, SHM_K = 64 * KP, SHM_V = 64 * DV * 2;
    constexpr int KSL = DQK / 8, NKS = 64 * KSL / 512, VSL = DV / 8, NVS = 64 * VSL / 512, W1S = (DQK == 192 ? 16 : 8);
    const int tid = otid(), wid = tid >> 6, lane = tid & 63, r32 = lane & 31, hi = lane >> 5;
    char* V_lds = lds; char* K_lds = lds + 2 * SHM_V;
    float* wsf = (float*)(lds + 2 * SHM_V + 2 * SHM_K) + wid * 64; float* li_l = wsf; float* al_l = wsf + 32;
    float* tab = (float*)(lds + 2 * SHM_V + 2 * SHM_K + 2048);
    __syncthreads();
    float m_reg = -1e30f, l_reg = 0; f32x16 o[NO]; bf16x8 qr[NQ];
#pragma unroll
    for (int d = 0; d < NO; ++d) o[d] = f32x16{};
    const int qgrow = A.r0 + (wid >> 1), rs = min(max(qgrow - 4, 0), 120), qc = (wid & 1) * 32 + r32, cs = min(max(qc - 8, 0), 48);
    const float* tabl = tab + 64 + 15 - qc + 4 * hi;
    const int vb0 = (int)(uintptr_t)V_lds + v_rd_base(lane);
    LAS unsigned char* Ll = (LAS unsigned char*)lds; const int widu = __builtin_amdgcn_readfirstlane(wid);
#define G0(j) ((j) < 4 ? A.ctxrow0 + 64 * (j) : A.latrow0 + 64 * ((j) - 4))
#define DMA(jt, b) do { const int g0_ = G0(jt); \
    _Pragma("unroll") for (int i = 0; i < NKS; ++i) { const int s_ = tid + 512 * i, row = s_ / KSL, c = (s_ % KSL) ^ ((row >> 1) & 7); const bf16_t* p_; \
        if (DQK == 192 && c >= W1S) p_ = A.K2 + (long)(g0_ + row) * A.ldk2 + (c - W1S) * 8; else p_ = A.K1 + (long)(g0_ + row) * A.ldk1 + c * 8; \
        __builtin_amdgcn_global_load_lds((const unsigned*)p_, (LAS unsigned*)(Ll + 2 * SHM_V + (b) * SHM_K + (i * 512 + widu * 64) * 16), 16, 0, 0); } \
    _Pragma("unroll") for (int i = 0; i < NVS; ++i) { const int off_ = (tid + 512 * i) * 16, st_ = off_ >> 9, wi_ = off_ & 511, kk_ = (st_ / NCB) * 8 + (wi_ >> 6); \
        const int k_ = (kk_ & ~0xC) | ((kk_ & 4) << 1) | ((kk_ & 8) >> 1), c_ = (st_ % NCB) * 32 + ((wi_ & 63) >> 1); \
        __builtin_amdgcn_global_load_lds((const unsigned*)(A.V + (long)(g0_ + k_) * A.ldv + c_), (LAS unsigned*)(Ll + (b) * SHM_V + (i * 512 + widu * 64) * 16), 16, 0, 0); } } while (0)
#define SWAIT() asm volatile("s_waitcnt vmcnt(0)" ::: "memory")
#define RESC(a) do { if (__any((a) < 1.f)) { if (hi == 0) al_l[r32] = (a); asm volatile("s_waitcnt lgkmcnt(0)" ::: "memory"); \
    _Pragma("unroll") for (int d = 0; d < NO; ++d) _Pragma("unroll") for (int r = 0; r < 16; ++r) o[d][r] *= al_l[crow(r, hi)]; } } while (0)
#define NAMASK(P0, P1, jt) do { if (NA) { if (A.masked && (jt) >= 4) { const int kr_ = A.krow0 + (jt) - 4; na_mask(P0, P1, tabl + (kr_ - qgrow + 7) * 31, (kr_ >= rs && kr_ < rs + 8), cs, hi); } } } while (0)
    f32x16 p0, p1; float mn, al; bf16x8 pa0, pa1, pa2, pa3; const int NT = A.NT;
    DMA(0, 0);
    if (NA && A.masked) { for (int i = tid; i < 465; i += 512) tab[64 + i] = A.rpb[i] * 8.f; }
    const bf16_t* Qw = A.Q + (long)(wid * 32 + r32) * A.ldq + hi * 8;
#pragma unroll
    for (int d0 = 0; d0 < NQ; ++d0) qr[d0] = *reinterpret_cast<const bf16x8*>(Qw + d0 * 16);
    if constexpr (!NA) {
        if (A.rope) {
            const f32x2* rt = A.rope + (long)(A.pos0 + wid * 32 + r32) * 32 + hi * 4;
#pragma unroll
            for (int d0 = 8; d0 < 12; ++d0) { bf16x8 v = qr[d0]; u32x4 w;
#pragma unroll
                for (int p = 0; p < 4; ++p) { const f32x2 cs = rt[(d0 - 8) * 8 + p]; const float x0 = bf2f((unsigned short)v[2 * p]), x1 = bf2f((unsigned short)v[2 * p + 1]);
                    w[p] = pk2(x0 * cs.x - x1 * cs.y, x0 * cs.y + x1 * cs.x); }
                qr[d0] = *reinterpret_cast<bf16x8*>(&w); }
        }
    }
    SWAIT(); __syncthreads();
    for (int j = 0; j < NT; ++j) {
        const int buf = j & 1;
        if (j + 1 < NT) DMA(j + 1, buf ^ 1);
        bool act = true;
        if (NA) { if (A.masked && j >= 4) { const int kr_ = A.krow0 + j - 4; act = (kr_ >= rs && kr_ < rs + 8); } }
        if (act) {
        SBAR(); qkt<DQK>(p0, p1, K_lds + buf * SHM_K, qr, r32, hi); NAMASK(p0, p1, j);
        partialSM(p0, p1, m_reg, mn, al, A.C, A.thr);
        finishSM(p0, p1, al, l_reg, pa0, pa1, pa2, pa3); RESC(al); SBAR();
        pv_all<DV>(o, vb0 + buf * SHM_V, pa0, pa1, pa2, pa3);
        }
        SWAIT();
        __syncthreads();
    }
    if (hi == 0) li_l[r32] = l_reg; asm volatile("s_waitcnt lgkmcnt(0)" ::: "memory");
    float rli[16];
#pragma unroll
    for (int r = 0; r < 16; ++r) rli[r] = __builtin_amdgcn_rcpf(li_l[crow(r, hi)]);
    bf16_t* Ow = A.O + (long)(wid * 32) * A.ldo;
#pragma unroll
    for (int r = 0; r < 16; ++r) { const int orow = crow(r, hi);
#pragma unroll
        for (int d0 = 0; d0 < NO; ++d0) Ow[(long)orow * A.ldo + d0 * 32 + r32] = f2bf(o[d0][r] * rli[r]); }
#undef G0
#undef DMA
#undef SWAIT
#undef RESC
#undef NAMASK
}
}

struct KArgs { const float* in[24]; float* out; unsigned char* ws; int lo, hi; };
enum { I_X = 0, I_C, I_CTX, I_CCTX, I_ADAW, I_ADAB, I_F1IN, I_F1OUT, I_F2IN, I_F2OUT, I_EWIN, I_WG2F, I_BGF, I_WG2B, I_BGB, I_GLANG, I_QNG, I_KVNG, I_WUQ, I_WUKV, I_EWOUT, I_NWIN, I_RPB, I_NWOUT };

__device__ __forceinline__ void transpose_item(const float* W, int K, int N, bf16_t* WT, int swiglu, LAS float* scr, int item, int lane) {
    const int nblk = N / 32, kb = item / nblk, nb = item % nblk, k0 = 64 * kb, n0 = 32 * nb;
    int rbase = n0;
    if (swiglu) { const int half = N / 2; const int up = n0 >= half; const int nn = up ? n0 - half : n0; rbase = (nn >> 7) * 256 + up * 128 + (nn & 127); }
    { float tv[32];
#pragma unroll
      for (int i = 0; i < 32; ++i) tv[i] = W[(size_t)(k0 + 2 * i + (lane >> 5)) * N + n0 + (lane & 31)];
#pragma unroll
      for (int i = 0; i < 32; ++i) scr[(2 * i + (lane >> 5)) * 33 + (lane & 31)] = tv[i]; }
    asm volatile("s_waitcnt lgkmcnt(0)" ::: "memory");
    const int c = lane & 7;
#pragma unroll
    for (int j = 0; j < 4; ++j) { const int n = (lane >> 3) + 8 * j; const LAS float* s = scr + (8 * c) * 33 + n;
        u32x4 o; o.x = pk2(s[0 * 33], s[1 * 33]); o.y = pk2(s[2 * 33], s[3 * 33]); o.z = pk2(s[4 * 33], s[5 * 33]); o.w = pk2(s[6 * 33], s[7 * 33]);
        *(u32x4*)(WT + (size_t)(rbase + n) * K + k0 + 8 * c) = o; }
    asm volatile("s_waitcnt lgkmcnt(0)" ::: "memory");
}

__device__ __forceinline__ void convert_layer(const KArgs& a, int l, int gw, int NGW, LAS float* scr, int lane) {
    unsigned char* ws = optr(a.ws);
    constexpr int I_IN = 16 * 176, I_OUT = 44 * 32, I_L = 2 * (I_IN + I_OUT);
    constexpr int I_EIN = 16 * 67, I_UQ = 6 * 24, I_UKV = 2 * 32, I_SQ = 16 * 32, I_E = I_EIN + I_UQ + I_UKV + I_SQ;
    constexpr int I_NIN = 16 * 96, I_O = I_NIN + I_SQ;
    const int i = l >> 1; const int nit = I_L + ((l & 1) ? I_O : I_E);
    unsigned char* wl = ws + OFF_W + (size_t)l * WL_BYTES; unsigned char* we = ws + OFF_WE + (size_t)i * 8 * MiB; unsigned char* wo = ws + OFF_WO + (size_t)i * 8 * MiB;
    for (int it = gw; it < nit; it += NGW) {
        int r = it;
        if (r < I_L) {
            if (r < I_IN) { transpose_item(a.in[I_F1IN] + (size_t)l * DM * 2 * DFF, DM, 2 * DFF, (bf16_t*)wl, 1, scr, r, lane); continue; } r -= I_IN;
            if (r < I_OUT) { transpose_item(a.in[I_F1OUT] + (size_t)l * DFF * DM, DFF, DM, (bf16_t*)(wl + W1OUT_O), 0, scr, r, lane); continue; } r -= I_OUT;
            if (r < I_IN) { transpose_item(a.in[I_F2IN] + (size_t)l * DM * 2 * DFF, DM, 2 * DFF, (bf16_t*)(wl + W2IN_O), 1, scr, r, lane); continue; } r -= I_IN;
            transpose_item(a.in[I_F2OUT] + (size_t)l * DFF * DM, DFF, DM, (bf16_t*)(wl + W2OUT_O), 0, scr, r, lane); continue; }
        r -= I_L;
        if (!(l & 1)) {
            if (r < I_EIN) { transpose_item(a.in[I_EWIN] + (size_t)i * DM * PW, DM, PW, (bf16_t*)we, 0, scr, r, lane); continue; } r -= I_EIN;
            if (r < I_UQ) { transpose_item(a.in[I_WUQ] + (size_t)i * 384 * 768, 384, 768, (bf16_t*)(we + WUQ_O), 0, scr, r, lane); continue; } r -= I_UQ;
            if (r < I_UKV) { transpose_item(a.in[I_WUKV] + (size_t)i * 128 * 1024, 128, 1024, (bf16_t*)(we + WUKV_O), 0, scr, r, lane); continue; } r -= I_UKV;
            transpose_item(a.in[I_EWOUT] + (size_t)i * DM * DM, DM, DM, (bf16_t*)(we + WEO_O), 0, scr, r, lane); }
        else {
            if (r < I_NIN) { transpose_item(a.in[I_NWIN] + (size_t)i * DM * 3072, DM, 3072, (bf16_t*)wo, 0, scr, r, lane); continue; } r -= I_NIN;
            transpose_item(a.in[I_NWOUT] + (size_t)i * DM * DM, DM, DM, (bf16_t*)(wo + WNO_O), 0, scr, r, lane); }
    }
}

__device__ __forceinline__ void phase_prep(const KArgs& a, unsigned char* lds_g) {
    unsigned char* wsq = optr(a.ws);
    LAS unsigned char* lds = (LAS unsigned char*)lds_g;
    const int tid = otid(), lane = tid & 63, wave = tid >> 6, G = gridDim.x;
    unsigned char* ws = wsq;
    convert_layer(a, 0, obid() * 8 + wave, G * 8, (LAS float*)(lds + wave * 16384), lane);
    {
        float* par = (float*)(ws + OFF_PAR); const int g0 = obid() * 512 + tid, gs = G * 512;
        for (int i = g0; i < 768; i += gs) par[PQ_QNG + i] = a.in[I_QNG][i];
        for (int i = g0; i < 256; i += gs) { par[PQ_KVNG + i] = a.in[I_KVNG][i]; par[PQ_GLANG + i] = a.in[I_GLANG][i]; }
        for (int i = g0; i < 8192; i += gs) { par[PQ_WG2F + i] = a.in[I_WG2F][i]; par[PQ_WG2B + i] = a.in[I_WG2B][i]; }
        for (int i = g0; i < 512; i += gs) { par[PQ_BGF + i] = a.in[I_BGF][i]; par[PQ_BGB + i] = a.in[I_BGB][i]; }
        for (int i = g0; i < 14880; i += gs) par[PQ_RPB + i] = a.in[I_RPB][i];
    }
    {
        f32x2* rope = (f32x2*)(ws + OFF_ROPE);
        for (int idx = obid() * 512 + tid; idx < SEQ * 32; idx += G * 512) {
            const int t = idx >> 5, i = idx & 31; const float pos = (float)((i < 16) ? (t >> 6) : (t & 63));
            const float inv = powf(10000.0f, -(float)(i & 15) / 16.0f); const float ang = pos * inv;
            rope[idx] = (f32x2){cosf(ang), sinf(ang)};
        }
    }
    __syncthreads();
    {
        LAS float* sl = (LAS float*)lds;
        LAS float* red = (LAS float*)(lds + 20480);
        for (int i = tid; i < 5 * 1024; i += 512) { const int r = i >> 10, k = i & 1023; const float v = (r < 4) ? a.in[I_C][r * 1024 + k] : a.in[I_CCTX][k]; sl[i] = v / (1.0f + __expf(-v)); }
        __syncthreads();
        float* mod = (float*)(ws + OFF_MOD);
        for (int item = obid(); item < 4 * 144; item += G) {
            const int l = item / 144, g = item % 144, col = tid & 63, ks = tid >> 6;
            const float* w = a.in[I_ADAW] + ((size_t)l * 1024 + ks * 128) * 9216 + g * 64 + col;
            const LAS float* s = sl + ks * 128;
            float a0 = 0, a1 = 0, a2 = 0, a3 = 0, a4 = 0;
            for (int k0 = 0; k0 < 128; k0 += 32) { float wv[32];
#pragma unroll
                for (int k = 0; k < 32; ++k) wv[k] = w[(size_t)(k0 + k) * 9216];
#pragma unroll
                for (int k = 0; k < 32; ++k) { a0 += s[k0 + k] * wv[k]; a1 += s[1024 + k0 + k] * wv[k]; a2 += s[2048 + k0 + k] * wv[k]; a3 += s[3072 + k0 + k] * wv[k]; a4 += s[4096 + k0 + k] * wv[k]; } }
            red[(ks * 5 + 0) * 64 + col] = a0; red[(ks * 5 + 1) * 64 + col] = a1; red[(ks * 5 + 2) * 64 + col] = a2; red[(ks * 5 + 3) * 64 + col] = a3; red[(ks * 5 + 4) * 64 + col] = a4;
            __syncthreads();
            if (tid < 320) { const int r = tid >> 6; float sum = a.in[I_ADAB][l * 9216 + g * 64 + col];
#pragma unroll
                for (int q = 0; q < 8; ++q) sum += red[(q * 5 + r) * 64 + col];
                mod[(size_t)(l * 5 + r) * 9216 + g * 64 + col] = sum; }
            __syncthreads();
        }
    }
}

__device__ __forceinline__ void phase_init_h(const KArgs& a) {
    unsigned char* wsq = optr(a.ws);
    const int lane = otid() & 63, gw = obid() * 8 + (otid() >> 6), NGW = gridDim.x * 8;
    const float* mod = (const float*)(wsq + OFF_MOD); bf16_t* Hb = (bf16_t*)(wsq + OFF_HB);
    f32x4 xv[4], nx[4];
#define IH_LOAD(XV, row_) do { const int r_ = (row_); const float* xs_ = (r_ < ML) ? a.in[I_X] + (size_t)r_ * DM : a.in[I_CTX] + (size_t)(r_ - ML) * DM; \
        _Pragma("unroll") for (int j = 0; j < 4; ++j) XV[j] = *(const f32x4*)(xs_ + 4 * lane + 256 * j); } while (0)
    if (gw < MR) IH_LOAD(xv, gw);
    for (int row = gw; row < MR; row += NGW) {
        if (row + NGW < MR) IH_LOAD(nx, row + NGW);
        const int rr = (row < ML) ? (row >> 13) : 4;
        const float* sh = mod + (size_t)rr * 9216; const float* sc = sh + 1024;
#pragma unroll
        for (int j = 0; j < 4; ++j) { const int c = 4 * lane + 256 * j; const f32x4 s1 = *(const f32x4*)(sc + c), s0 = *(const f32x4*)(sh + c);
            const f32x4 h = xv[j] * (1.0f + s1) + s0; u32x2 w; w.x = pk2(h[0], h[1]); w.y = pk2(h[2], h[3]); *(u32x2*)(Hb + (size_t)row * DM + c) = w; }
#pragma unroll
        for (int j = 0; j < 4; ++j) xv[j] = nx[j];
    }
#undef IH_LOAD
}

__device__ __forceinline__ void phase_ln(const float* xl_src, const float* xc_src, float* xl_dst, float* xc_dst, const bf16_t* Y, int ldy,
                                         const float* modg, float coef, const float* modh, bf16_t* Hb, const bf16_t* PART, int nparts) {
    const int lane = otid() & 63, gw = obid() * 8 + (otid() >> 6), NGW = gridDim.x * 8;
    f32x4 xv[4], nxv[4]; u32x2 yv[4], nyv[4]; f32x4 gq[4], s0q[4], s1q[4]; int cur_rr = -1;
#pragma unroll
    for (int j = 0; j < 4; ++j) { gq[j] = (f32x4){0.f, 0.f, 0.f, 0.f}; s0q[j] = gq[j]; s1q[j] = gq[j]; }
#define LN_LOAD(XV, YV, row_) do { const int r_ = (row_); const bool lat_ = r_ < ML; \
        const float* xs_ = lat_ ? xl_src + (size_t)r_ * DM : xc_src + (size_t)(r_ - ML) * DM; const bf16_t* y_ = Y + (size_t)r_ * ldy; \
        _Pragma("unroll") for (int j = 0; j < 4; ++j) { const int c = 4 * lane + 256 * j; XV[j] = *(const f32x4*)(xs_ + c); YV[j] = *(const u32x2*)(y_ + c); } } while (0)
    if (gw < MR) LN_LOAD(xv, yv, gw);
    for (int row = gw; row < MR; row += NGW) {
        const bool lat = row < ML; const int rr = lat ? (row >> 13) : 4;
        if (row + NGW < MR) LN_LOAD(nxv, nyv, row + NGW);
        float* xd = lat ? xl_dst + (size_t)row * DM : xc_dst + (size_t)(row - ML) * DM;
        if (rr != cur_rr) { cur_rr = rr;
#pragma unroll
            for (int j = 0; j < 4; ++j) { const int c = 4 * lane + 256 * j; gq[j] = *(const f32x4*)(modg + (size_t)rr * 9216 + c) * coef;
                if (modh) { s0q[j] = *(const f32x4*)(modh + (size_t)rr * 9216 + c); s1q[j] = *(const f32x4*)(modh + (size_t)rr * 9216 + 1024 + c) + 1.0f; } } }
        f32x4 t[4]; float s = 0.f;
#pragma unroll
        for (int j = 0; j < 4; ++j) { const int c = 4 * lane + 256 * j; const f32x4 gg = gq[j]; const u32x2 yw = yv[j];
            f32x4 yy;
            if (lat) { yy[0] = __uint_as_float(yw.x << 16); yy[1] = __uint_as_float(yw.x & 0xffff0000u); yy[2] = __uint_as_float(yw.y << 16); yy[3] = __uint_as_float(yw.y & 0xffff0000u); }
            else { yy = (f32x4){0.f, 0.f, 0.f, 0.f};
                u32x2 pw[11];
#pragma unroll
                for (int p = 0; p < 11; ++p) { pw[p] = (u32x2){0u, 0u}; if (p < nparts) pw[p] = *(const u32x2*)(PART + ((size_t)p * 1024 + (row - ML)) * 1024 + c); }
#pragma unroll
                for (int p = 0; p < 11; ++p) { yy[0] += __uint_as_float(pw[p].x << 16); yy[1] += __uint_as_float(pw[p].x & 0xffff0000u); yy[2] += __uint_as_float(pw[p].y << 16); yy[3] += __uint_as_float(pw[p].y & 0xffff0000u); } }
            t[j] = xv[j] * ALPHA + gg * yy; s += (t[j][0] + t[j][1]) + (t[j][2] + t[j][3]); }
        const float mean = wave_sum(s) * (1.0f / DM); float s2 = 0.f;
#pragma unroll
        for (int j = 0; j < 4; ++j) { t[j] = t[j] - mean; s2 += (t[j][0] * t[j][0] + t[j][1] * t[j][1]) + (t[j][2] * t[j][2] + t[j][3] * t[j][3]); }
        const float rstd = 1.0f / sqrtf(wave_sum(s2) * (1.0f / DM) + LN_EPS);
#pragma unroll
        for (int j = 0; j < 4; ++j) { const int c = 4 * lane + 256 * j; const f32x4 xn = t[j] * rstd; *(f32x4*)(xd + c) = xn;
            if (modh) { const f32x4 h = xn * s1q[j] + s0q[j];
                u32x2 w; w.x = pk2(h[0], h[1]); w.y = pk2(h[2], h[3]); *(u32x2*)(Hb + (size_t)row * DM + c) = w; } }
#pragma unroll
        for (int j = 0; j < 4; ++j) { xv[j] = nxv[j]; yv[j] = nyv[j]; }
    }
#undef LN_LOAD
}

__device__ __forceinline__ void phase_evenD(bf16_t* P, const float* qng, const float* kvng, const f32x2* rope) {
    const int lane = otid() & 63, gw = obid() * 8 + (otid() >> 6), NGW = gridDim.x * 8;
    const float g0 = qng[2 * lane], g1 = qng[2 * lane + 1], g2 = qng[2 * lane + 128], g3 = qng[2 * lane + 129], g4 = qng[2 * lane + 256], g5 = qng[2 * lane + 257];
    const float k0 = kvng[2 * lane], k1 = kvng[2 * lane + 1];
    unsigned w0, w1, w2, wk, wr; f32x2 cs; unsigned n0, n1, n2, nk, nr; f32x2 ncs;
#define ED_LOAD(W0, W1, W2, WK, WR, CS, row_) do { const bf16_t* p_ = P + (size_t)(row_) * PW; W0 = *(const unsigned*)(p_ + PC_CQ + 2 * lane); W1 = *(const unsigned*)(p_ + PC_CQ + 2 * lane + 128); \
        W2 = *(const unsigned*)(p_ + PC_CQ + 2 * lane + 256); WK = *(const unsigned*)(p_ + PC_CKV + 2 * lane); WR = *(const unsigned*)(p_ + PC_KR + 2 * (lane & 31)); \
        CS = rope[(size_t)((row_) & (SEQ - 1)) * 32 + (lane & 31)]; } while (0)
    if (gw < MR) ED_LOAD(w0, w1, w2, wk, wr, cs, gw);
    for (int row = gw; row < MR; row += NGW) {
        if (row + NGW < MR) ED_LOAD(n0, n1, n2, nk, nr, ncs, row + NGW);
        bf16_t* pr = P + (size_t)row * PW;
        { const float x0 = __uint_as_float(w0 << 16), x1 = __uint_as_float(w0 & 0xffff0000u), x2 = __uint_as_float(w1 << 16), x3 = __uint_as_float(w1 & 0xffff0000u), x4 = __uint_as_float(w2 << 16), x5 = __uint_as_float(w2 & 0xffff0000u);
          const float y0 = __uint_as_float(wk << 16), y1 = __uint_as_float(wk & 0xffff0000u);
          float ss = (x0 * x0 + x1 * x1) + (x2 * x2 + x3 * x3) + (x4 * x4 + x5 * x5), sk = y0 * y0 + y1 * y1;
#pragma unroll
          for (int o = 1; o < 64; o <<= 1) { ss += __shfl_xor(ss, o); sk += __shfl_xor(sk, o); }
          const float rs = __builtin_amdgcn_rsqf(ss * (1.0f / 384.0f) + LN_EPS), rk = __builtin_amdgcn_rsqf(sk * (1.0f / 128.0f) + LN_EPS);
          *(unsigned*)(pr + PC_CQ + 2 * lane) = pk2(x0 * rs * g0, x1 * rs * g1); *(unsigned*)(pr + PC_CQ + 2 * lane + 128) = pk2(x2 * rs * g2, x3 * rs * g3); *(unsigned*)(pr + PC_CQ + 2 * lane + 256) = pk2(x4 * rs * g4, x5 * rs * g5);
          *(unsigned*)(pr + PC_CKV + 2 * lane) = pk2(y0 * rk * k0, y1 * rk * k1); }
        if (row < ML && lane < 32) { const float x0 = __uint_as_float(wr << 16), x1 = __uint_as_float(wr & 0xffff0000u);
          *(unsigned*)(pr + PC_KR + 2 * lane) = pk2(x0 * cs.x - x1 * cs.y, x0 * cs.y + x1 * cs.x); }
        w0 = n0; w1 = n1; w2 = n2; wk = nk; wr = nr; cs = ncs;
    }
#undef ED_LOAD
}

__device__ __forceinline__ f32x16 mma_nt(const bf16_t* X, int ldx, const bf16_t* Y, int ldy, int nk, f32x16 acc, int r32, int hi) {
    for (int kk = 0; kk < nk; ++kk) { const bf16x8 a = *(const bf16x8*)(X + r32 * ldx + kk * 16 + hi * 8); const bf16x8 b = *(const bf16x8*)(Y + r32 * ldy + kk * 16 + hi * 8);
        acc = __builtin_amdgcn_mfma_f32_32x32x16_bf16(a, b, acc, 0, 0, 0); }
    return acc;
}
__device__ __forceinline__ int chunk_row0(int b, int cid) { return cid < 4 ? ML + b * CTXL + cid * 64 : b * SEQ + (cid - 4) * 64; }

#define LBAR() do { asm volatile("s_waitcnt lgkmcnt(0)" ::: "memory"); __builtin_amdgcn_s_barrier(); asm volatile("" ::: "memory"); } while (0)
__device__ __forceinline__ void gla_gates(const float* par, int ie, int h, int tid, const float* lrs, float* gs, float* qs) {
    const int dir = (tid >> 6) & 1, d = tid & 63, tq = tid >> 7;
    const float* wg = par + (dir ? PQ_WG2B : PQ_WG2F) + ie * 16 * 256 + h * 64 + d; const float bias = par[(dir ? PQ_BGB : PQ_BGF) + ie * 256 + h * 64 + d];
    float w[16];
#pragma unroll
    for (int j = 0; j < 16; ++j) w[j] = wg[j * 256];
    float run = 0.f;
#pragma unroll 4
    for (int tt = 0; tt < 16; ++tt) { const int t = tq * 16 + (dir ? 15 - tt : tt); float x = bias;
        const f32x4* lr4 = (const f32x4*)(lrs + t * 32 + dir * 16);
#pragma unroll
        for (int j4 = 0; j4 < 4; ++j4) { const f32x4 l = lr4[j4]; x += l[0] * w[4 * j4] + l[1] * w[4 * j4 + 1] + l[2] * w[4 * j4 + 2] + l[3] * w[4 * j4 + 3]; }
        run += logsig16(x); gs[(dir * 64 + t) * 64 + d] = run; }
    qs[(dir * 64 + d) * 4 + tq] = run;
}
__device__ __forceinline__ float gla_offset(const float* qs, int dir, int d, int tq, float& tot) {
    const f32x4 q = *(const f32x4*)(qs + (dir * 64 + d) * 4); tot = (q[0] + q[1]) + (q[2] + q[3]);
    float off = 0.f;
    if (dir == 0) { if (tq > 0) off += q[0]; if (tq > 1) off += q[1]; if (tq > 2) off += q[2]; }
    else { if (tq < 3) off += q[3]; if (tq < 2) off += q[2]; if (tq < 1) off += q[1]; }
    return off;
}
#define GLA_DECODE(uu, h_, cid_, b_, row0_) const int h_ = (uu) & 3, cid_ = ((uu) >> 2) % NCH, b_ = (uu) / (4 * NCH); const int row0_ = chunk_row0(b_, cid_)
__device__ __forceinline__ void phase_gla_c1(const KArgs& a, int ie, char* lds) {
    unsigned char* wsq = optr(a.ws);
    const float* par = (const float*)(wsq + OFF_PAR);
    const int tid = otid(), wid = tid >> 6, lane = tid & 63, r32 = lane & 31, hi = lane >> 5;
    const bf16_t* P = (const bf16_t*)(wsq + OFF_R); bf16_t* SL = (bf16_t*)(wsq + OFF_R + R_SL); float* DEC = (float*)(wsq + OFF_R + R_DEC);
    float* lrs = (float*)lds; float* gs = (float*)(lds + 8192); bf16_t* kdT = (bf16_t*)(lds + 40960); bf16_t* vT = (bf16_t*)(lds + 59392); bf16_t* Ks = (bf16_t*)(lds + 77824); float* qs = (float*)(lds + 86016);
    const int NU = NB * NCH * 4, G = gridDim.x;
    bf16x8 pk, pv0, pv1, plv;
#define C1_LOAD(uu) do { GLA_DECODE(uu, h_, cid_, b_, row0_); (void)cid_; (void)b_; \
        pk = *(const bf16x8*)(P + (size_t)(row0_ + (tid >> 3)) * PW + PC_K + h_ * 64 + (tid & 7) * 8); \
        pv0 = *(const bf16x8*)(P + (size_t)(row0_ + (tid & 63)) * PW + PC_V + h_ * 128 + (tid >> 6) * 8); \
        pv1 = *(const bf16x8*)(P + (size_t)(row0_ + (tid & 63)) * PW + PC_V + h_ * 128 + 64 + (tid >> 6) * 8); \
        plv = *(const bf16x8*)(P + (size_t)(row0_ + ((tid & 255) >> 2)) * PW + PC_LRF + (tid & 3) * 8); } while (0)
    int u = obid();
    if (u < NU) C1_LOAD(u);
    for (; u < NU; u += G) {
        GLA_DECODE(u, h, cid, b, row0); (void)row0;
        LBAR();
        *(bf16x8*)(Ks + tid * 8) = pk;
#pragma unroll
        for (int q = 0; q < 8; ++q) { vT[((tid >> 6) * 8 + q) * 72 + (tid & 63)] = (bf16_t)pv0[q]; vT[(64 + (tid >> 6) * 8 + q) * 72 + (tid & 63)] = (bf16_t)pv1[q]; }
        if (tid < 256) {
#pragma unroll
            for (int q = 0; q < 8; ++q) lrs[tid * 8 + q] = bf2f((unsigned short)plv[q]); }
        if (u + G < NU) C1_LOAD(u + G);
        LBAR();
        gla_gates(par, ie, h, tid, lrs, gs, qs);
        LBAR();
        { const int dir = (tid >> 6) & 1, d = tid & 63, tq = tid >> 7; float tot; const float off = gla_offset(qs, dir, d, tq, tot);
#pragma unroll 4
          for (int tt = 0; tt < 16; ++tt) { const int t = tq * 16 + tt; const float run = gs[(dir * 64 + t) * 64 + d] + off;
              kdT[(dir * 64 + d) * 72 + t] = f2bf(bf2f(Ks[t * 64 + d]) * __expf(tot - run)); }
          if (tq == 0) DEC[((size_t)((b * 2 + dir) * 4 + h) * NCH + cid) * 64 + d] = __expf(tot); }
        LBAR();
#pragma unroll
        for (int q = 0; q < 2; ++q) { const int ti = wid + 8 * q, dir = ti >> 3, ct = (ti >> 1) & 3, dt = ti & 1;
            f32x16 acc = f32x16{}; acc = mma_nt(vT + ct * 32 * 72, 72, kdT + (dir * 64 + dt * 32) * 72, 72, 4, acc, r32, hi);
            bf16_t* dst = SL + ((size_t)((b * 2 + dir) * 4 + h) * NCH + cid) * 8192;
#pragma unroll
            for (int r = 0; r < 16; ++r) dst[(ct * 32 + crow(r, hi)) * 64 + dt * 32 + r32] = f2bf(acc[r]); }
    }
    LBAR();
#undef C1_LOAD
}
__device__ __forceinline__ void phase_gla_c2(const KArgs& a) {
    unsigned char* wsq = optr(a.ws);
    bf16_t* SL = (bf16_t*)(wsq + OFF_R + R_SL); const float* DEC = (const float*)(wsq + OFF_R + R_DEC);
    for (int gid = obid() * 512 + otid(); gid < 32 * 4096; gid += gridDim.x * 512) {
        const int bdh = gid >> 12, e = (gid & 4095) * 2, d = e & 63, dir = (bdh >> 2) & 1;
        float S0 = 0.f, S1 = 0.f;
        unsigned loc[12], nloc[12]; f32x2 dd[12], ndd[12];
#define C2_LOAD(L, D, s0_) do { _Pragma("unroll") for (int q = 0; q < 12; ++q) { const int s = (s0_) + q; const int cid = dir ? (s < 4 ? 3 - s : 135 - s) : s; const size_t idx = (size_t)bdh * NCH + cid; \
            L[q] = *(const unsigned*)(SL + idx * 8192 + e); D[q] = *(const f32x2*)(DEC + idx * 64 + d); } } while (0)
        C2_LOAD(loc, dd, 0);
        for (int s0 = 0; s0 < NCH; s0 += 12) {
            if (s0 + 12 < NCH) C2_LOAD(nloc, ndd, s0 + 12);
#pragma unroll
            for (int q = 0; q < 12; ++q) { const int s = s0 + q; const int cid = dir ? (s < 4 ? 3 - s : 135 - s) : s; const size_t idx = (size_t)bdh * NCH + cid;
                *(unsigned*)(SL + idx * 8192 + e) = pk2(S0, S1); S0 = S0 * dd[q].x + __uint_as_float(loc[q] << 16); S1 = S1 * dd[q].y + __uint_as_float(loc[q] & 0xffff0000u); }
#pragma unroll
            for (int q = 0; q < 12; ++q) { loc[q] = nloc[q]; dd[q] = ndd[q]; }
        }
#undef C2_LOAD
    }
}
__device__ __forceinline__ void phase_gla_c3(const KArgs& a, int ie, char* lds) {
    unsigned char* wsq = optr(a.ws);
    const float* par = (const float*)(wsq + OFF_PAR);
    const int tid = otid(), wid = tid >> 6, lane = tid & 63, r32 = lane & 31, hi = lane >> 5;
    const bf16_t* P = (const bf16_t*)(wsq + OFF_R); const bf16_t* SL = (const bf16_t*)(wsq + OFF_R + R_SL); bf16_t* CAT = (bf16_t*)(wsq + OFF_HB);
    float* lrs = (float*)lds; bf16_t* QE = (bf16_t*)(lds + 8192); bf16_t* KE = (bf16_t*)(lds + 25600); bf16_t* VT = (bf16_t*)(lds + 44032);
    bf16_t* ST = (bf16_t*)(lds + 62464); float* gs = (float*)(lds + 62464);
    bf16_t* AM = (bf16_t*)(lds + 97280); float* part = (float*)(lds + 106496); bf16_t* Ks = (bf16_t*)(lds + 107520); bf16_t* Qs = (bf16_t*)(lds + 115712); float* qs = (float*)(lds + 123904);
    const float* ng = par + PQ_GLANG + ie * 128;
    const int NU = NB * NCH * 4, G = gridDim.x;
    const int oit = wid >> 2, oct = wid & 3;
    bf16x8 pk, pq, pv0, pv1, plv, psv[4]; bf16_t prg[16];
#define C3_LOAD_A(uu) do { GLA_DECODE(uu, h_, cid_, b_, row0_); (void)cid_; (void)b_; \
        pk = *(const bf16x8*)(P + (size_t)(row0_ + (tid >> 3)) * PW + PC_K + h_ * 64 + (tid & 7) * 8); \
        pq = *(const bf16x8*)(P + (size_t)(row0_ + (tid >> 3)) * PW + PC_Q + h_ * 64 + (tid & 7) * 8); \
        pv0 = *(const bf16x8*)(P + (size_t)(row0_ + (tid & 63)) * PW + PC_V + h_ * 128 + (tid >> 6) * 8); \
        pv1 = *(const bf16x8*)(P + (size_t)(row0_ + (tid & 63)) * PW + PC_V + h_ * 128 + 64 + (tid >> 6) * 8); \
        plv = *(const bf16x8*)(P + (size_t)(row0_ + ((tid & 255) >> 2)) * PW + PC_LRF + (tid & 3) * 8); } while (0)
#define C3_LOAD_B(uu) do { GLA_DECODE(uu, h_, cid_, b_, row0_); \
        _Pragma("unroll") for (int q = 0; q < 4; ++q) { const int i = tid + 512 * q, dir = i >> 10, c = (i >> 3) & 127, d8 = (i & 7) * 8; \
            psv[q] = *(const bf16x8*)(SL + ((size_t)((b_ * 2 + dir) * 4 + h_) * NCH + cid_) * 8192 + c * 64 + d8); } \
        _Pragma("unroll") for (int r = 0; r < 16; ++r) prg[r] = P[(size_t)(row0_ + oit * 32 + crow(r, hi)) * PW + PC_R + h_ * 128 + oct * 32 + r32]; } while (0)
    int u = obid();
    if (u < NU) { C3_LOAD_A(u); C3_LOAD_B(u); }
    for (; u < NU; u += G) {
        GLA_DECODE(u, h, cid, b, row0); (void)cid; (void)b;
        bf16_t crg[16];
#pragma unroll
        for (int r = 0; r < 16; ++r) crg[r] = prg[r];
        LBAR();
        *(bf16x8*)(Ks + tid * 8) = pk; *(bf16x8*)(Qs + tid * 8) = pq;
#pragma unroll
        for (int q = 0; q < 8; ++q) { VT[((tid >> 6) * 8 + q) * 72 + (tid & 63)] = (bf16_t)pv0[q]; VT[(64 + (tid >> 6) * 8 + q) * 72 + (tid & 63)] = (bf16_t)pv1[q]; }
        if (tid < 256) {
#pragma unroll
            for (int q = 0; q < 8; ++q) lrs[tid * 8 + q] = bf2f((unsigned short)plv[q]); }
        if (u + G < NU) C3_LOAD_A(u + G);
        LBAR();
        gla_gates(par, ie, h, tid, lrs, gs, qs);
        LBAR();
        { const int dir = (tid >> 6) & 1, d = tid & 63, tq = tid >> 7; float tot; const float off = gla_offset(qs, dir, d, tq, tot); (void)tot;
#pragma unroll 4
          for (int tt = 0; tt < 16; ++tt) { const int t = tq * 16 + tt; const float run = gs[(dir * 64 + t) * 64 + d] + off;
              const float q = bf2f(Qs[t * 64 + d]) * 0.125f, k = bf2f(Ks[t * 64 + d]);
              QE[t * 136 + dir * 64 + d] = f2bf(q * __expf(run)); KE[(dir * 64 + t) * 72 + d] = f2bf(k * __expf(-run)); } }
        LBAR();
#pragma unroll
        for (int q = 0; q < 4; ++q) { const int i = tid + 512 * q, dir = i >> 10, c = (i >> 3) & 127, d8 = (i & 7) * 8; *(bf16x8*)(ST + c * 136 + dir * 64 + d8) = psv[q]; }
        { const int tile = wid & 3, dir = wid >> 2, it = tile >> 1, jt = tile & 1;
          f32x16 acc = f32x16{}; acc = mma_nt(QE + it * 32 * 136 + dir * 64, 136, KE + (dir * 64 + jt * 32) * 72, 72, 4, acc, r32, hi);
#pragma unroll
          for (int r = 0; r < 16; ++r) { const int i = it * 32 + crow(r, hi), j = jt * 32 + r32; const bool own = dir ? (i < j) : (i >= j); if (own) AM[i * 72 + j] = f2bf(acc[r]); } }
        if (u + G < NU) C3_LOAD_B(u + G);
        LBAR();
        { const int it = oit, ct = oct;
          f32x16 acc = f32x16{}; acc = mma_nt(AM + it * 32 * 72, 72, VT + ct * 32 * 72, 72, 4, acc, r32, hi);
          acc = mma_nt(QE + it * 32 * 136, 136, ST + ct * 32 * 136, 136, 8, acc, r32, hi);
          float ss[16];
#pragma unroll
          for (int r = 0; r < 16; ++r) { float v = acc[r] * acc[r]; v += __shfl_xor(v, 1); v += __shfl_xor(v, 2); v += __shfl_xor(v, 4); v += __shfl_xor(v, 8); v += __shfl_xor(v, 16); ss[r] = v; }
          if (r32 == 0) {
#pragma unroll
              for (int r = 0; r < 16; ++r) part[ct * 64 + it * 32 + crow(r, hi)] = ss[r]; }
          const int c = ct * 32 + r32; const float gn = ng[c];
          LBAR();
#pragma unroll
          for (int r = 0; r < 16; ++r) { const int i = it * 32 + crow(r, hi); const float tot = part[i] + part[64 + i] + part[128 + i] + part[192 + i];
              const float rs = __builtin_amdgcn_rsqf(tot * (1.0f / 128.0f) + LN_EPS); const float rg = bf2f(crg[r]);
              CAT[(size_t)(row0 + i) * DM + h * 128 + c] = f2bf(acc[r] * rs * gn * (rg * __builtin_amdgcn_rcpf(1.0f + __expf(-rg)))); } }
    }
    LBAR();
#undef C3_LOAD_A
#undef C3_LOAD_B
}

__device__ __forceinline__ void phase_mla(const KArgs& a, char* lds) {
    unsigned char* wsq = optr(a.ws);
    const bf16_t* P = (const bf16_t*)(wsq + OFF_R); const bf16_t* QB = (const bf16_t*)(wsq + OFF_R + R_QB); const bf16_t* KVB = (const bf16_t*)(wsq + OFF_R + R_KVB);
    bf16_t* CAT = (bf16_t*)(wsq + OFF_HB);
    const float scale = 0.07216878364870322f;
    const int G_ = (int)gridDim.x, bi_ = obid(), nlat_ = (512 - bi_ + G_ - 1) / G_;
    for (int i = 0;; ++i) {
        int id;
        if (i < nlat_) id = i * G_ + bi_;
        else if (i == nlat_ && G_ >= 16 && bi_ >= G_ - 16) id = 512 + (bi_ - (G_ - 16));
        else if (G_ < 16 && 512 + (i - nlat_) * G_ + bi_ < 528) id = 512 + (i - nlat_) * G_ + bi_;
        else break;
        fa::Args A; int b, h;
        if (id < 512) { const int c = id & 255, rnd = id >> 8; const int bh = (c & 7) + 8 * rnd, qb = c >> 3; b = bh >> 2; h = bh & 3;
            const int qrow = b * SEQ + qb * 256; A.Q = QB + (size_t)qrow * 768 + h * 192; A.O = CAT + (size_t)qrow * DM + 512 + h * 128; A.NT = NCH; A.rope = (const f32x2*)(wsq + OFF_ROPE); A.pos0 = qb * 256; }
        else { const int c = id - 512; b = c >> 2; h = c & 3; const int qrow = ML + b * CTXL; A.Q = QB + (size_t)qrow * 768 + h * 192; A.O = CAT + (size_t)qrow * DM + 512 + h * 128; A.NT = 4; A.rope = nullptr; A.pos0 = 0; }
        A.ldq = 768; A.ldo = DM; A.K1 = KVB + h * 256; A.ldk1 = 1024; A.K2 = P + PC_KR; A.ldk2 = PW; A.V = KVB + h * 256 + 128; A.ldv = 1024;
        A.ctxrow0 = ML + b * CTXL; A.latrow0 = b * SEQ; A.C = scale * 1.4426950408889634f; A.thr = 8.0f / scale; A.rpb = nullptr; A.masked = 0; A.r0 = 0; A.krow0 = 0;
#ifndef NO_MLA
        fa::flash_unit<192, 128, false>(lds, A);
#endif
    }
}
__device__ __forceinline__ void phase_na(const KArgs& a, int io, char* lds) {
    unsigned char* wsq = optr(a.ws);
    const bf16_t* QKV = (const bf16_t*)(wsq + OFF_R); bf16_t* CAT = (bf16_t*)(wsq + OFF_HB);
    for (int i = 0;; ++i) {
        const int id = i * gridDim.x + obid(); if (id >= 2048 + 64) break;
        fa::Args A; int b, h;
        if (id < 2048) { const int rb = ((id & 7) << 2) | ((id >> 3) & 3);     h = (id >> 5) & 15; b = id >> 9; const int qrow = b * SEQ + rb * 256; const int r0 = rb * 4, krow0 = min(max(r0 - 4, 0), 116);
            A.Q = QKV + (size_t)qrow * 3072 + h * 64; A.O = CAT + (size_t)qrow * DM + h * 64; A.NT = 16; A.masked = 1; A.r0 = r0; A.krow0 = krow0; A.latrow0 = b * SEQ + krow0 * 64;
            A.rpb = (const float*)(wsq + OFF_PAR) + PQ_RPB + (size_t)(io * 16 + h) * 465; }
        else { const int c = id - 2048; b = c >> 4; h = c & 15; const int qrow = ML + b * CTXL;
            A.Q = QKV + (size_t)qrow * 3072 + h * 64; A.O = CAT + (size_t)qrow * DM + h * 64; A.NT = 4; A.masked = 0; A.r0 = 0; A.krow0 = 0; A.latrow0 = 0; A.rpb = nullptr; }
        A.ldq = 3072; A.ldo = DM; A.K1 = QKV + 1024 + h * 64; A.ldk1 = 3072; A.K2 = nullptr; A.ldk2 = 0; A.V = QKV + 2048 + h * 64; A.ldv = 3072;
        A.ctxrow0 = ML + b * CTXL; A.C = 0.125f * 1.4426950408889634f; A.thr = 64.0f; A.rope = nullptr; A.pos0 = 0;
#ifndef NO_NA
        fa::flash_unit<64, 64, true>(lds, A);
#endif
    }
}

#define XB_TMO      128
#define XB_XCNT(j)  (256  + 64 * (j))
#define XB_XSUB(j)  (1280 + 64 * (j))
#define XB_XGEN(j)  (2304 + 64 * (j))
#define XB_TOP      3328
#define XB_TOPGEN   3392
#define XCD_BAR_WORDS 3456
#define XB_SPIN_CAP (1u << 18)
__device__ __forceinline__ unsigned xb_ld(unsigned* p)              { return __hip_atomic_load(p, __ATOMIC_RELAXED, __HIP_MEMORY_SCOPE_AGENT); }
__device__ __forceinline__ unsigned xb_add(unsigned* p, unsigned v) { return __hip_atomic_fetch_add(p, v, __ATOMIC_RELAXED, __HIP_MEMORY_SCOPE_AGENT); }
__device__ __forceinline__ unsigned xb_xcc_id() { return (unsigned)__builtin_amdgcn_s_getreg((3 << 11) | 20) & 0xFu; }
#define XB_SPIN(cond, bar) do { unsigned _sp = 0; while (cond) { __builtin_amdgcn_s_sleep(1); \
    if ((++_sp & 255u) == 0u) { if (xb_ld(&(bar)[XB_TMO])) break; if (_sp > XB_SPIN_CAP) { atomicAdd(&(bar)[XB_TMO], 1u); break; } } } } while (0)
__device__ __forceinline__ void xcd_barrier_complete(unsigned* bar, unsigned x, unsigned& nloc, unsigned& nx) {
    const unsigned G = gridDim.x * gridDim.y * gridDim.z;
    unsigned sum, cnt, mine, sp = 0u;
    for (;;) {
        sum = 0u; cnt = 0u; mine = 0u;
#pragma unroll
        for (unsigned j = 0; j < 16; ++j) { const unsigned c = xb_ld(&bar[XB_XCNT(j)]); sum += c; cnt += (c > 0u) ? 1u : 0u; mine = (j == x) ? c : mine; }
        if (sum == G) break;
        __builtin_amdgcn_s_sleep(1);
        if ((++sp & 255u) == 0u) { if (xb_ld(&bar[XB_TMO])) break; if (sp > XB_SPIN_CAP) { atomicAdd(&bar[XB_TMO], 1u); break; } }
    }
    nloc = mine > 0u ? mine : 1u; nx = cnt > 0u ? cnt : 1u;
}
__device__ __forceinline__ void xcd_barrier(unsigned* bar, volatile LAS unsigned* st) {
    asm volatile("s_waitcnt vmcnt(0)" ::: "memory");
    __syncthreads();
    if (threadIdx.x == 0) {
        __builtin_amdgcn_s_waitcnt(0);
        const unsigned x = xb_xcc_id();
        unsigned nloc = st[0], nx = st[1];
        if (nloc == 0u) { xcd_barrier_complete(bar, x, nloc, nx); st[0] = nloc; st[1] = nx; }
        const unsigned old = xb_add(&bar[XB_XSUB(x)], 1u);
        const unsigned gen = old / nloc;
        if (old + 1u == (gen + 1u) * nloc) {
            __builtin_amdgcn_fence(__ATOMIC_RELEASE, "agent");
            asm volatile("s_waitcnt vmcnt(0)" ::: "memory");
            const unsigned og = xb_add(&bar[XB_TOP], 1u);
            const unsigned tg = og / nx;
            if (og + 1u == (tg + 1u) * nx) xb_add(&bar[XB_TOPGEN], 1u);
            else XB_SPIN(xb_ld(&bar[XB_TOPGEN]) == tg, bar);
            __builtin_amdgcn_fence(__ATOMIC_ACQUIRE, "agent");
            xb_add(&bar[XB_XGEN(x)], 1u);
            asm volatile("s_waitcnt vmcnt(0)" ::: "memory");
        } else {
            XB_SPIN(xb_ld(&bar[XB_XGEN(x)]) == gen, bar);
            __builtin_amdgcn_fence(__ATOMIC_ACQUIRE, "agent");
            asm volatile("s_waitcnt vmcnt(0)" ::: "memory");
        }
    }
    __syncthreads();
}

constexpr int LDS_BYTES = 147456;
constexpr int NPH = 2 + 4 * 12;

__global__ void __launch_bounds__(512, 2) mega(KArgs a) {
    extern __shared__ __attribute__((aligned(16))) unsigned char lds[];
    cg::grid_group grid = cg::this_grid();
    volatile LAS unsigned* bst = (volatile LAS unsigned*)((LAS unsigned char*)lds + 131072 + 64);
    unsigned* bar = (unsigned*)(a.ws + OFF_BAR);
    if (threadIdx.x == 0) { bst[0] = 0u; bst[1] = 0u; (void)xb_add(&bar[XB_XCNT(xb_xcc_id())], 1u); }
    __syncthreads();
    bool first = true;
    if (a.lo == 0) {
        for (int rep = 0; rep < 1 + ((DUP >> 5) & 1); ++rep) { phase_prep(a, lds); __syncthreads(); }
        if (a.hi < 0) grid.sync();
        xcd_barrier((unsigned*)(optr(a.ws) + OFF_BAR), bst);
        phase_init_h(a);
        first = false;
    }
    for (int ph = (a.lo < 2 ? 2 : a.lo); ph < a.hi; ++ph) {
        int l = 0, st = -1;
        if (ph >= 2) { l = (ph - 2) / 12; st = (ph - 2) % 12; }
        const bool odd = (l & 1) != 0; const int ie = l >> 1;
        if (ph >= 2 && odd && (st == 5 || st == 6)) continue;
        if (!first) { xcd_barrier((unsigned*)(optr(a.ws) + OFF_BAR), bst); if ((DUP >> 6) & 1) xcd_barrier((unsigned*)(optr(a.ws) + OFF_BAR), bst); }
        first = false;
        unsigned char* ws = optr(a.ws);
        float* mod = (float*)(ws + OFF_MOD); bf16_t* Hb = (bf16_t*)(ws + OFF_HB); float* Xc = (float*)(ws + OFF_XC);
        unsigned char* wl = ws + OFF_W + (size_t)l * WL_BYTES; unsigned char* we = ws + OFF_WE + (size_t)ie * 8 * MiB; unsigned char* wo = ws + OFF_WO + (size_t)ie * 8 * MiB;
        const float* modl = mod + (size_t)l * 5 * 9216;
        if (st == 0 || st == 9) {
            pg8::Gemm g{Hb, (const bf16_t*)(wl + (st == 0 ? 0 : W2IN_O)), MR, 2 * DFF, DM, DM, DM};
            pg8::StaticOrder S; S.init((l == 3 && st == 9) ? ML : MR, 2 * DFF, DM, gridDim.x, obid(), 0);
            pg8::EpiSwiglu E{(bf16_t*)(ws + OFF_R), DFF};
            for (int rep = 0; rep < 1 + ((DUP >> 3) & 1); ++rep) pg8::gemm_phase<pg8::EpiSwiglu>((LAS unsigned char*)lds, g, S, E);
            if (st == 0 && l < 3) {
                const int bi = obid(), nfree = (int)gridDim.x - 88;
                if (nfree > 0 && bi >= 88) { const int otw = otid(); convert_layer(a, l + 1, (bi - 88) * 8 + (otw >> 6), nfree * 8, (LAS float*)((LAS unsigned char*)lds + (otw >> 6) * 16384), otw & 63); }
                else if (nfree <= 0) { const int otw = otid(); convert_layer(a, l + 1, bi * 8 + (otw >> 6), (int)gridDim.x * 8, (LAS float*)((LAS unsigned char*)lds + (otw >> 6) * 16384), otw & 63); }
            }
        }
        else if (st == 1 || st == 3 || st == 5 || st == 7 || st == 10) {
            const int nsub = (st == 5) ? 2 : 1;
            for (int sub = 0; sub < nsub; ++sub) {
                pg8::Gemm g; pg8::EpiStore E; bf16_t* PARTB = (bf16_t*)(ws + OFF_R + R_PART);
                if (st == 1 || st == 10) { g = pg8::Gemm{(const bf16_t*)(ws + OFF_R), (const bf16_t*)(wl + (st == 1 ? W1OUT_O : W2OUT_O)), MR, DM, DFF, DFF, DFF}; E = pg8::EpiStore{Hb, DM, DM, PARTB}; }
                else if (st == 3) {
                    if (!odd) { g = pg8::Gemm{Hb, (const bf16_t*)we, MR, 2304, DM, DM, DM}; E = pg8::EpiStore{(bf16_t*)(ws + OFF_R), PW, PW, nullptr}; }
                    else { g = pg8::Gemm{Hb, (const bf16_t*)wo, MR, 3072, DM, DM, DM}; E = pg8::EpiStore{(bf16_t*)(ws + OFF_R), 3072, 3072, nullptr}; }
                }
                else if (st == 5) {
                    if (sub == 0) { g = pg8::Gemm{(const bf16_t*)(ws + OFF_R) + PC_CQ, (const bf16_t*)(we + WUQ_O), MR, 768, 384, PW, 384}; E = pg8::EpiStore{(bf16_t*)(ws + OFF_R + R_QB), 768, 768, nullptr}; }
                    else { g = pg8::Gemm{(const bf16_t*)(ws + OFF_R) + PC_CKV, (const bf16_t*)(we + WUKV_O), MR, 1024, 128, PW, 128}; E = pg8::EpiStore{(bf16_t*)(ws + OFF_R + R_KVB), 1024, 1024, nullptr}; }
                }
                else { g = pg8::Gemm{Hb, (const bf16_t*)(odd ? wo + WNO_O : we + WEO_O), MR, DM, DM, DM, DM}; E = pg8::EpiStore{(bf16_t*)(ws + OFF_R + (odd ? R_YODD : 0)), DM, DM, PARTB}; }
                const int cblk = (st == 5 && sub == 1 && gridDim.x > 144) ? (int)((obid() + gridDim.x - 144) % gridDim.x) : obid();
                pg8::StaticOrder S; S.init(g.M, g.N, g.K, gridDim.x, cblk, (st == 1 || st == 10 || st == 7) ? 1 : 0); if (l == 3 && st == 10) S.nextra = 0;
                for (int rep = 0; rep < 1 + (((DUP >> 4) & 1) & (st == 1 || st == 10)); ++rep) pg8::gemm_phase<pg8::EpiStore>((LAS unsigned char*)lds, g, S, E);
            }
#ifndef NO_C2
            if (st == 5) phase_gla_c2(a);
#endif
        }
        else if (st == 2 || st == 8 || st == 11) {
            const float* xl_src = (l == 0 && st == 2) ? a.in[I_X] : a.out; const float* xc_src = (l == 0 && st == 2) ? a.in[I_CTX] : Xc;
            const bf16_t* Y = (st == 8) ? (const bf16_t*)(ws + OFF_R + (odd ? R_YODD : 0)) : Hb;
            const float* modg = modl + (st == 2 ? 2 : st == 8 ? 5 : 8) * 1024; const float coef = (st == 8) ? 1.0f : 0.5f;
            const float* modh = (st == 2) ? modl + 3 * 1024 : (st == 8) ? modl + 6 * 1024 : (l < 3 ? modl + 5 * 9216 : nullptr);
            if (((DUP >> 7) & 1) && st != 8) phase_ln(xl_src, xc_src, (float*)(ws + OFF_R), (float*)(ws + OFF_R + 128 * MiB), Y, DM, modg, coef, modh, (bf16_t*)(ws + OFF_R + 140 * MiB), (const bf16_t*)(ws + OFF_R + R_PART), (st == 8) ? 4 : 11);
            phase_ln(xl_src, xc_src, a.out, Xc, Y, DM, modg, coef, modh, Hb, (const bf16_t*)(ws + OFF_R + R_PART), (st == 8) ? 4 : 11);
        }
        else if (st == 4) {
            if (!odd) { phase_evenD((bf16_t*)(ws + OFF_R), (const float*)(ws + OFF_PAR) + PQ_QNG + ie * 384, (const float*)(ws + OFF_PAR) + PQ_KVNG + ie * 128, (const f32x2*)(ws + OFF_ROPE));
 for (int rep = 0; rep < 1 + ((DUP >> 2) & 1); ++rep) phase_gla_c1(a, ie, (char*)lds);
 }
            else for (int rep = 0; rep < 1 + ((DUP >> 1) & 1); ++rep) phase_na(a, ie, (char*)lds);
        }
        else if (st == 6) { for (int rep = 0; rep < 1 + ((DUP >> 0) & 1); ++rep) phase_mla(a, (char*)lds);
 for (int rep = 0; rep < 1 + ((DUP >> 2) & 1); ++rep) phase_gla_c3(a, ie, (char*)lds);
 }
    }
}

extern "C" void kernel_launch(void* const* d_in, const int* in_sizes, int n_in, void* d_out, int out_size, void* d_ws, size_t ws_size, hipStream_t stream) {
    static int grid = 0;
    if (grid == 0) {
        if (n_in != 24 || in_sizes[0] != ML * DM || out_size != ML * DM || ws_size < WS_END) {
            fprintf(stderr, "kernel_launch: unexpected shapes (n_in %d, in0 %d, out %d, ws %zu need %zu); nothing launched\n", n_in, n_in > 0 ? in_sizes[0] : -1, out_size, ws_size, (size_t)WS_END); grid = -1; return; }
        int dev = 0, cus = 0, per_cu = 0;
        hipGetDevice(&dev); hipDeviceGetAttribute(&cus, hipDeviceAttributeMultiprocessorCount, dev);
        if (hipFuncSetAttribute((const void*)mega, hipFuncAttributeMaxDynamicSharedMemorySize, LDS_BYTES) != hipSuccess) { fprintf(stderr, "kernel_launch: hipFuncSetAttribute failed\n"); grid = -1; return; }
        if (hipOccupancyMaxActiveBlocksPerMultiprocessor(&per_cu, (const void*)mega, 512, LDS_BYTES) != hipSuccess || per_cu < 1) { fprintf(stderr, "kernel_launch: occupancy query says %d blocks per CU\n", per_cu); per_cu = 1; }
        (void)hipGetLastError();
        grid = cus * per_cu;
    }
    if (grid < 0) return;
    KArgs a{};
    for (int i = 0; i < 24; ++i) a.in[i] = (const float*)d_in[i];
    a.out = (float*)d_out; a.ws = (unsigned char*)d_ws; a.lo = 0; a.hi = DBG_HI;
    (void)hipMemsetAsync((char*)d_ws + OFF_BAR, 0, 16384, stream);
    void* args[] = {&a};
    hipError_t e = hipLaunchCooperativeKernel((const void*)mega, dim3(grid), dim3(512), args, LDS_BYTES, stream);
    if (e != hipSuccess) fprintf(stderr, "kernel_launch: cooperative launch failed: %s (grid %d)\n", hipGetErrorString(e), grid);
}
```
